# Optimizing an MI355X kernel written in HIP

```python
import jax
import jax.numpy as jnp
from jax import lax

D_MODEL = 1024
BATCH = 2
SEQ = 8192
DEPTH = 1

HEAD_DIM = 64
WIN_Q_HEADS = 8
WIN_KV_HEADS = 2
WIN_HALF = 128
DIL_SLOTS = 8
DIL_PAIRS = ((128, 1), (512, 4), (2048, 16))
N_DIL = len(DIL_PAIRS)
ROT_DIM = HEAD_DIM // 4
ROPE_THETA = 500000.0
MEM_LEN = 256
X_HEADS = 4
X_HEAD_DIM = D_MODEL // X_HEADS
D_FF = 2816
CONV_WIDTH = 3
WIN_WIDTH = WIN_Q_HEADS * HEAD_DIM
DIL_WIDTH = DIL_SLOTS * HEAD_DIM
MIX_WIDTH = WIN_WIDTH + DIL_WIDTH
A_Q = WIN_WIDTH
A_KV = WIN_KV_HEADS * HEAD_DIM
B_QKV = N_DIL * DIL_WIDTH
IN_WIDTH = A_Q + 2 * A_KV + 3 * B_QKV
SPLITS = (A_Q, A_Q + A_KV, A_Q + 2 * A_KV, A_Q + 2 * A_KV + B_QKV, A_Q + 2 * A_KV + 2 * B_QKV)
DEEPNORM_ALPHA = (2 * DEPTH) ** 0.25
DEEPNORM_BETA = (8 * DEPTH) ** -0.25
LN_EPS = 1e-5
NEG_INF = -1e30
POS_OFFSET_MAX = 4096

kernel_name = 'hymba_window_dilated_deepnorm_encoder'


def layer_norm(x, g, b):
    xf = x.astype(jnp.float32)
    mu = jnp.mean(xf, -1, keepdims=True)
    var = jnp.mean(jnp.square(xf - mu), -1, keepdims=True)
    return ((xf - mu) * lax.rsqrt(var + LN_EPS) * g + b).astype(x.dtype)


def rms_norm(x, g):
    xf = x.astype(jnp.float32)
    return (xf * lax.rsqrt(jnp.mean(jnp.square(xf), -1, keepdims=True) + LN_EPS) * g).astype(x.dtype)


def partial_rope(t, positions):
    half = ROT_DIM // 2
    inv_freq = ROPE_THETA ** (-jnp.arange(0, ROT_DIM, 2, dtype=jnp.float32) / ROT_DIM)
    ang = positions.astype(jnp.float32)[:, :, None] * inv_freq
    cos = jnp.cos(ang)[:, :, None, :]
    sin = jnp.sin(ang)[:, :, None, :]
    tr = t[..., :ROT_DIM].astype(jnp.float32)
    t1, t2 = tr[..., :half], tr[..., half:]
    rot = jnp.concatenate([t1 * cos - t2 * sin, t2 * cos + t1 * sin], -1).astype(t.dtype)
    return jnp.concatenate([rot, t[..., ROT_DIM:]], -1)


def banded_attention(q, k, v, n_side, sink=None):
    bt, seq_len, hkv, grp, dh = q.shape
    blk = n_side
    nb = -(-seq_len // blk)
    pad = nb * blk - seq_len
    qb = jnp.pad(q, ((0, 0), (0, pad), (0, 0), (0, 0), (0, 0))).reshape(bt, nb, blk, hkv, grp, dh)

    def neighbourhood(t):
        tp = jnp.pad(t, ((0, 0), (blk, blk + pad), (0, 0), (0, 0))).reshape(bt, nb + 2, blk, hkv, dh)
        return jnp.concatenate([tp[:, :-2], tp[:, 1:-1], tp[:, 2:]], axis=2)

    kw = neighbourhood(k)
    vw = neighbourhood(v)
    s = jnp.einsum('bnqhgd,bnkhd->bnhgqk', qb, kw).astype(jnp.float32) * (dh ** -0.5)
    qi = jnp.arange(blk)[:, None]
    kj = jnp.arange(3 * blk)[None, :]
    kabs = jnp.arange(nb)[:, None, None] * blk + kj[None] - blk
    mask = (jnp.abs(kj - blk - qi) <= n_side)[None] & (kabs >= 0) & (kabs < seq_len)
    mask = mask[None, :, None, None]
    s = jnp.where(mask, s, NEG_INF)
    m = jnp.max(s, -1)
    if sink is not None:
        sink_f = sink.astype(jnp.float32)[None, None, :, :, None]
        m = jnp.maximum(m, sink_f)
    p = jnp.where(mask, jnp.exp(s - m[..., None]), 0.0)
    denom = jnp.sum(p, -1)
    if sink is not None:
        denom = denom + jnp.exp(sink_f - m)
    o = jnp.einsum('bnhgqk,bnkhd->bnqhgd', p, vw.astype(jnp.float32))
    o = o / jnp.moveaxis(denom, -1, 2)[..., None]
    o = o.astype(q.dtype).reshape(bt, nb * blk, hkv, grp, dh)[:, :seq_len]
    lse = jnp.moveaxis(m + jnp.log(denom), -1, 2).reshape(bt, nb * blk, hkv, grp)[:, :seq_len]
    return o, lse


def to_residue(t, r):
    b, s = t.shape[:2]
    t = t.reshape((b, s // r, r) + t.shape[2:])
    t = jnp.moveaxis(t, 2, 1)
    return t.reshape((b * r, s // r) + t.shape[3:])


def from_residue(t, r, batch):
    t = t.reshape((batch, r) + t.shape[1:])
    t = jnp.moveaxis(t, 1, 2)
    return t.reshape((batch, t.shape[1] * r) + t.shape[3:])


def parallel_mixer(h, positions, w_in, attn_sink, g_win, g_dil, w_out):
    b, s, _ = h.shape
    z = h @ w_in
    qa, ka, va, qb, kb, vb = jnp.split(z, SPLITS, axis=-1)
    qa = partial_rope(qa.reshape(b, s, WIN_Q_HEADS, HEAD_DIM), positions)
    ka = partial_rope(ka.reshape(b, s, WIN_KV_HEADS, HEAD_DIM), positions)
    va = va.reshape(b, s, WIN_KV_HEADS, HEAD_DIM)
    qa = qa.reshape(b, s, WIN_KV_HEADS, WIN_Q_HEADS // WIN_KV_HEADS, HEAD_DIM)
    out_a, _ = banded_attention(qa, ka, va, WIN_HALF, attn_sink.reshape(WIN_KV_HEADS, -1))
    out_a = out_a.reshape(b, s, WIN_WIDTH)
    n_heads_b = N_DIL * DIL_SLOTS
    qb = partial_rope(qb.reshape(b, s, n_heads_b, HEAD_DIM), positions).reshape(b, s, N_DIL, DIL_SLOTS, HEAD_DIM)
    kb = partial_rope(kb.reshape(b, s, n_heads_b, HEAD_DIM), positions).reshape(b, s, N_DIL, DIL_SLOTS, HEAD_DIM)
    vb = vb.reshape(b, s, N_DIL, DIL_SLOTS, HEAD_DIM)
    outs = []
    lses = []
    for gi, (window, dil) in enumerate(DIL_PAIRS):
        n_side = window // (2 * dil)
        o, lse = banded_attention(to_residue(qb[:, :, gi], dil)[:, :, :, None],
                                  to_residue(kb[:, :, gi], dil),
                                  to_residue(vb[:, :, gi], dil), n_side)
        outs.append(from_residue(o[:, :, :, 0], dil, b))
        lses.append(from_residue(lse[..., 0], dil, b))
    wts = jax.nn.softmax(jnp.stack(lses), axis=0)[..., None]
    out_b = jnp.sum(wts * jnp.stack(outs).astype(jnp.float32), axis=0).astype(h.dtype).reshape(b, s, DIL_WIDTH)
    mixed = jnp.concatenate([rms_norm(out_a, g_win), rms_norm(out_b, g_dil)], -1)
    return mixed @ w_out


def memory_cross_attention(h, mem_n, w_q, w_k, w_v, w_o):
    b, s, _ = h.shape
    m_len = mem_n.shape[1]
    q = (h @ w_q).reshape(b, s, X_HEADS, X_HEAD_DIM)
    k = (mem_n @ w_k).reshape(b, m_len, X_HEADS, X_HEAD_DIM)
    v = (mem_n @ w_v).reshape(b, m_len, X_HEADS, X_HEAD_DIM)
    sc = jnp.einsum('bshd,bmhd->bhsm', q, k).astype(jnp.float32) * (X_HEAD_DIM ** -0.5)
    p = jax.nn.softmax(sc, axis=-1)
    o = jnp.einsum('bhsm,bmhd->bshd', p, v.astype(jnp.float32)).astype(h.dtype)
    return o.reshape(b, s, D_MODEL) @ w_o


def conv_glu(h, w_gate, w_up, conv_w, conv_b, w_down):
    s = h.shape[1]
    g = h @ w_gate
    half = CONV_WIDTH // 2
    gp = jnp.pad(g, ((0, 0), (half, half), (0, 0)))
    g = sum(gp[:, j:j + s] * conv_w[j] for j in range(CONV_WIDTH)) + conv_b
    return (jax.nn.gelu(g, approximate=False) * (h @ w_up)) @ w_down


def setup_inputs(seed: int = 0) -> dict:
    key = jax.random.key(seed)
    keys = list(jax.random.split(key, 40))
    f32 = jnp.float32
    d = D_MODEL
    nl = DEPTH
    beta = DEEPNORM_BETA

    def normal(shape, scale):
        return jax.random.normal(keys.pop(), shape, f32) * scale

    def gain(shape):
        return 1.0 + normal(shape, 0.02)

    def bias(shape):
        return normal(shape, 0.02)

    in_scale = jnp.concatenate([jnp.ones((A_Q + A_KV,), f32), jnp.full((A_KV,), beta, f32),
                                jnp.ones((2 * B_QKV,), f32), jnp.full((B_QKV,), beta, f32)])
    x = normal((BATCH, SEQ, d), 1.0)
    mem = normal((BATCH, MEM_LEN, d), 1.0)
    positions = jnp.arange(SEQ, dtype=jnp.int32)[None, :] + jax.random.randint(
        keys.pop(), (BATCH, 1), 0, POS_OFFSET_MAX, dtype=jnp.int32)
    return {
        'x': x,
        'mem': mem,
        'positions': positions,
        'ln_in_g': gain((d,)),
        'ln_in_b': bias((d,)),
        'w_in': normal((nl, d, IN_WIDTH), d ** -0.5) * in_scale,
        'attn_sink': normal((nl, WIN_Q_HEADS), 0.5),
        'g_win': gain((nl, WIN_WIDTH)),
        'g_dil': gain((nl, DIL_WIDTH)),
        'w_mix_out': normal((nl, MIX_WIDTH, d), MIX_WIDTH ** -0.5 * beta),
        'ln1_g': gain((nl, d)),
        'ln1_b': bias((nl, d)),
        'mem_ln_g': gain((nl, d)),
        'mem_ln_b': bias((nl, d)),
        'w_xq': normal((nl, d, d), d ** -0.5),
        'w_xk': normal((nl, d, d), d ** -0.5),
        'w_xv': normal((nl, d, d), d ** -0.5 * beta),
        'w_xo': normal((nl, d, d), d ** -0.5 * beta),
        'ln2_g': gain((nl, d)),
        'ln2_b': bias((nl, d)),
        'w_gate': normal((nl, d, D_FF), d ** -0.5),
        'w_up': normal((nl, d, D_FF), d ** -0.5 * beta),
        'conv_w': normal((nl, CONV_WIDTH, D_FF), CONV_WIDTH ** -0.5),
        'conv_b': bias((nl, D_FF)),
        'w_down': normal((nl, D_FF, d), D_FF ** -0.5 * beta),
        'ln3_g': gain((nl, d)),
        'ln3_b': bias((nl, d)),
    }


def reference(x, mem, positions, ln_in_g, ln_in_b, w_in, attn_sink, g_win, g_dil, w_mix_out,
              ln1_g, ln1_b, mem_ln_g, mem_ln_b, w_xq, w_xk, w_xv, w_xo, ln2_g, ln2_b,
              w_gate, w_up, conv_w, conv_b, w_down, ln3_g, ln3_b):
    h = layer_norm(x, ln_in_g, ln_in_b)
    for l in range(DEPTH):
        mix = parallel_mixer(h, positions, w_in[l], attn_sink[l], g_win[l], g_dil[l], w_mix_out[l])
        h = layer_norm(DEEPNORM_ALPHA * h + mix, ln1_g[l], ln1_b[l])
        mem_n = layer_norm(mem, mem_ln_g[l], mem_ln_b[l])
        xa = memory_cross_attention(h, mem_n, w_xq[l], w_xk[l], w_xv[l], w_xo[l])
        h = layer_norm(DEEPNORM_ALPHA * h + xa, ln2_g[l], ln2_b[l])
        ff = conv_glu(h, w_gate[l], w_up[l], conv_w[l], conv_b[l], w_down[l])
        h = layer_norm(DEEPNORM_ALPHA * h + ff, ln3_g[l], ln3_b[l])
    return h
```

```cpp
#include <hip/hip_runtime.h>
#include <hip/hip_cooperative_groups.h>
#include <cstdio>
#include <cstdint>
namespace cg = cooperative_groups;

#ifndef MK_N_LAUNCHES
#define MK_N_LAUNCHES 1
#endif

namespace pg8 {
#define PG8_LAS __attribute__((address_space(3)))
typedef unsigned short bf16_t;
typedef short bf16x8 __attribute__((ext_vector_type(8)));
typedef float f32x4 __attribute__((ext_vector_type(4)));
typedef float f32x2 __attribute__((ext_vector_type(2)));
typedef unsigned u32x4 __attribute__((ext_vector_type(4)));
constexpr int BM = 256, BK = 64, HALF = 128, HTB = HALF * BK * 2, STAGE_BYTES = 8 * HTB, NXCD = 8, WGM = 8;

__host__ __device__ __forceinline__ int lds_byte(int r, int c) { const int st = (r >> 4) * 2 + (c >> 5), rr = r & 15, cc = c & 31, ob = rr * 64 + cc * 2; return st * 1024 + (ob ^ (((ob >> 9) & 1) << 5)); }
__host__ __device__ __forceinline__ void stage_rc(int b, int& R, int& C) { const int st = b / 1024, sb = b % 1024, swz = sb ^ (((sb >> 9) & 1) << 5); R = (st >> 1) * 16 + swz / 64; C = (st & 1) * 32 + (swz % 64) / 2; }
__host__ __device__ __forceinline__ int perm32(int rho) { const int n = rho >> 4, i = rho & 15; return 8 * (i >> 2) + 4 * n + (i & 3); }

struct Unit { int pm, pn; };

struct StaticOrder {
    int nM, nN, nwg, G, c;
    __host__ __device__ void init(int M, int N, int G_, int c_) { nM = M / BM; nN = N / BM; nwg = nM * nN; G = G_; c = c_; }
    __host__ __device__ bool next(int i, Unit& u) const {
        const long L = (long)i * G + c; if (L >= nwg) return false;
        int wgid = (int)L; { const int q = nwg / NXCD, r = nwg % NXCD, xcd = wgid % NXCD, off = wgid / NXCD; wgid = (xcd < r ? xcd * (q + 1) : r * (q + 1) + (xcd - r) * q) + off; }
        const int nig = WGM * nN, gid = wgid / nig, fm = gid * WGM, gsz = (nM - fm) < WGM ? (nM - fm) : WGM;
        u.pm = fm + ((wgid % nig) % gsz); u.pn = (wgid % nig) / gsz; return true;
    }
};

struct AddrPlain { const bf16_t* A; const bf16_t* Bt; int lda, ldb;
    __device__ __forceinline__ const char* a(const Unit& u) const { return (const char*)(A + (size_t)u.pm * BM * lda); }
    __device__ __forceinline__ const char* b(const Unit& u) const { return (const char*)(Bt + (size_t)u.pn * BM * ldb); } };
struct AddrBatchB { const bf16_t* A; const bf16_t* Bt; int lda, ldb;
    __device__ __forceinline__ const char* a(const Unit& u) const { return (const char*)(A + (size_t)u.pm * BM * lda); }
    __device__ __forceinline__ const char* b(const Unit& u) const { return (const char*)(Bt + ((size_t)(u.pm >> 5) * 1024 + (size_t)u.pn * BM) * ldb); } };
struct AddrG { const bf16_t* KV; const bf16_t* wq; int lda, ldb;
    __device__ __forceinline__ const char* a(const Unit& u) const { return (const char*)(KV + (size_t)(u.pm >> 2) * 256 * 2048 + (u.pm & 3) * 256); }
    __device__ __forceinline__ const char* b(const Unit& u) const { return (const char*)(wq + (size_t)u.pn * 256 * 1024 + (u.pm & 3) * 256); } };
struct AddrH { const bf16_t* woT; const bf16_t* KV; int lda, ldb;
    __device__ __forceinline__ const char* a(const Unit& u) const { return (const char*)(woT + (size_t)(u.pm & 3) * 256 * 1024 + u.pn * 256); }
    __device__ __forceinline__ const char* b(const Unit& u) const { return (const char*)(KV + (size_t)(u.pm >> 2) * 256 * 2048 + 1024 + u.pn * 256); } };

__device__ __forceinline__ unsigned cvt_pk_bf16(float lo, float hi) { unsigned r; asm volatile("v_cvt_pk_bf16_f32 %0, %1, %2" : "=v"(r) : "v"(lo), "v"(hi)); return r; }

struct EpiBf16 {
    static constexpr bool PERM = true, AFTER_DRAIN = false;
    bf16_t* O; int ldc; float sc;
    __device__ __forceinline__ void operator()(const f32x4 (&acc)[2][2][4][2], const Unit& u, int wr, int wc, int fr, int fq) const {
        const int row0 = u.pm * BM + wr * 64 + fr; const int col0 = u.pn * BM + wc * 32 + 8 * fq;
#pragma unroll
        for (int ai = 0; ai < 2; ++ai)
#pragma unroll
            for (int m = 0; m < 4; ++m) { bf16_t* rowp = O + (size_t)(row0 + ai * HALF + m * 16) * ldc + col0;
#pragma unroll
                for (int bj = 0; bj < 2; ++bj) { f32x4 v0 = acc[ai][bj][m][0] * sc, v1 = acc[ai][bj][m][1] * sc;
                    u32x4 w; w.x = cvt_pk_bf16(v0[0], v0[1]); w.y = cvt_pk_bf16(v0[2], v0[3]); w.z = cvt_pk_bf16(v1[0], v1[1]); w.w = cvt_pk_bf16(v1[2], v1[3]);
                    *(u32x4*)(rowp + bj * HALF) = w; } }
    }
};
struct EpiF32 {
    static constexpr bool PERM = true, AFTER_DRAIN = false;
    float* O; int ldc;
    __device__ __forceinline__ void operator()(const f32x4 (&acc)[2][2][4][2], const Unit& u, int wr, int wc, int fr, int fq) const {
        const int row0 = u.pm * BM + wr * 64 + fr; const int col0 = u.pn * BM + wc * 32 + 8 * fq;
#pragma unroll
        for (int ai = 0; ai < 2; ++ai)
#pragma unroll
            for (int m = 0; m < 4; ++m) { float* rowp = O + (size_t)(row0 + ai * HALF + m * 16) * ldc + col0;
#pragma unroll
                for (int bj = 0; bj < 2; ++bj) { *(f32x4*)(rowp + bj * HALF) = acc[ai][bj][m][0]; *(f32x4*)(rowp + bj * HALF + 4) = acc[ai][bj][m][1]; } }
    }
};

template <class Epi, class Sched, class Addr, bool ALIGN_EPI>
__device__ __forceinline__ void gemm_phase(PG8_LAS unsigned char* lds, const Addr& G, const int K, const Sched& S, const Epi& E) {
    const int tid = threadIdx.x, wid = __builtin_amdgcn_readfirstlane(tid >> 6), lane = tid & 63, wr = wid >> 2, wc = wid & 3, fr = lane & 15, fq = lane >> 4;
    const int nt = K / BK;
    const int lda = G.lda, ldb = G.ldb;
    unsigned voffA[2], voffB[2];
#pragma unroll
    for (int i = 0; i < 2; ++i) { int R, C; stage_rc(tid * 16 + i * 8192, R, C); const int Rb = Epi::PERM ? ((R & ~31) + perm32(R & 31)) : R;
        voffA[i] = (unsigned)(R * lda + C) * 2u; voffB[i] = (unsigned)(Rb * ldb + C) * 2u; }
    const size_t kstep = (size_t)(BK * 2);
    const size_t hsA = (size_t)HALF * lda * 2, hsB = (size_t)HALF * ldb * 2;
    const unsigned ldsw = (unsigned)wid * 1024u;
    const int aoff = lds_byte(wr * 64 + fr, fq * 8), boff = lds_byte(wc * 32 + fr, fq * 8);
#define PG8_SA(b, h) (((b) * 2 + (h)) * HTB)
#define PG8_SB(b, h) ((4 + (b) * 2 + (h)) * HTB)
#define PG8_STAGE(bufoff, gbase, voff) do { _Pragma("unroll") for (int _i = 0; _i < 2; ++_i) \
        __builtin_amdgcn_global_load_lds((const unsigned*)((const char*)(gbase) + (voff)[_i]), (PG8_LAS unsigned*)(lds + (bufoff) + ldsw + _i * 8192), 16, 0, 0); } while (0)
#define PG8_LDA(dst, b, h) do { _Pragma("unroll") for (int m = 0; m < 4; ++m) _Pragma("unroll") for (int k = 0; k < 2; ++k) dst[m][k] = *(const PG8_LAS bf16x8*)(lds + PG8_SA(b, h) + aoff + m * 2048 + k * 1024); } while (0)
#define PG8_LDB(dst, b, h) do { _Pragma("unroll") for (int n = 0; n < 2; ++n) _Pragma("unroll") for (int k = 0; k < 2; ++k) dst[n][k] = *(const PG8_LAS bf16x8*)(lds + PG8_SB(b, h) + boff + n * 2048 + k * 1024); } while (0)
#define PG8_MMA(ai, bj, At, Bt) do { __builtin_amdgcn_s_setprio(1); _Pragma("unroll") for (int m = 0; m < 4; ++m) _Pragma("unroll") for (int n = 0; n < 2; ++n) _Pragma("unroll") for (int k = 0; k < 2; ++k) \
        acc[ai][bj][m][n] = __builtin_amdgcn_mfma_f32_16x16x32_bf16(Bt[n][k], At[m][k], acc[ai][bj][m][n], 0, 0, 0); __builtin_amdgcn_s_setprio(0); } while (0)
#define PG8_WAIT_V(n) asm volatile("s_waitcnt vmcnt(" #n ")" ::: "memory")
#define PG8_WAIT_L(n) asm volatile("s_waitcnt lgkmcnt(" #n ")" ::: "memory")
#define PG8_BAR __builtin_amdgcn_s_barrier()
#define PG8_SCHED __builtin_amdgcn_sched_barrier(0)
    Unit cur, nxt; int ui = 0;
    if (!S.next(0, cur)) return;
    f32x4 acc[2][2][4][2];
#pragma unroll
    for (int a = 0; a < 2; ++a)
#pragma unroll
        for (int b = 0; b < 2; ++b)
#pragma unroll
            for (int m = 0; m < 4; ++m)
#pragma unroll
                for (int n = 0; n < 2; ++n) acc[a][b][m][n] = (f32x4){0.f, 0.f, 0.f, 0.f};
    bf16x8 At[4][2], B0[2][2], B1[2][2];
    const char* cA = G.a(cur); const char* cB = G.b(cur);
    PG8_STAGE(PG8_SB(0, 0), cB, voffB); PG8_STAGE(PG8_SB(0, 1), cB + hsB, voffB); PG8_STAGE(PG8_SA(0, 0), cA, voffA); PG8_STAGE(PG8_SA(0, 1), cA + hsA, voffA);
    if (wr == 1) PG8_BAR;
    PG8_WAIT_V(2); PG8_BAR;
    PG8_STAGE(PG8_SB(1, 0), cB + kstep, voffB); PG8_STAGE(PG8_SA(1, 0), cA + kstep, voffA); PG8_STAGE(PG8_SB(1, 1), cB + hsB + kstep, voffB);
    PG8_WAIT_V(6); PG8_BAR;
    for (;;) {
        const bool has_next = S.next(ui + 1, nxt);
        const char* nA = has_next ? G.a(nxt) : cA; const char* nB = has_next ? G.b(nxt) : cB;
#pragma unroll 1
        for (int t = 0; t < nt; t += 2) {
            const bool last = (t == nt - 2);
            const char* a1 = cA + (size_t)(t + 1) * kstep;
            const char* a2 = last ? nA : cA + (size_t)(t + 2) * kstep; const char* b2 = last ? nB : cB + (size_t)(t + 2) * kstep;
            const char* a3 = a2 + kstep; const char* b3 = b2 + kstep;
            PG8_LDB(B0, 0, 0); PG8_LDB(B1, 0, 1); PG8_SCHED; PG8_LDA(At, 0, 0); PG8_STAGE(PG8_SA(1, 1), a1 + hsA, voffA);
            PG8_WAIT_V(8); PG8_WAIT_L(0); PG8_BAR; PG8_MMA(0, 0, At, B0); PG8_MMA(0, 1, At, B1); PG8_BAR; PG8_SCHED;
            PG8_LDA(At, 0, 1); PG8_STAGE(PG8_SB(0, 0), b2, voffB); PG8_STAGE(PG8_SB(0, 1), b2 + hsB, voffB); PG8_STAGE(PG8_SA(0, 0), a2, voffA);
            PG8_WAIT_V(8); PG8_WAIT_L(0); PG8_BAR; PG8_MMA(1, 0, At, B0); PG8_MMA(1, 1, At, B1); PG8_BAR; PG8_SCHED;
            PG8_LDB(B0, 1, 0); PG8_LDB(B1, 1, 1); PG8_SCHED; PG8_LDA(At, 1, 0); PG8_STAGE(PG8_SA(0, 1), a2 + hsA, voffA);
            PG8_WAIT_V(8); PG8_WAIT_L(0); PG8_BAR; PG8_MMA(0, 0, At, B0); PG8_MMA(0, 1, At, B1); PG8_BAR; PG8_SCHED;
            PG8_LDA(At, 1, 1); PG8_STAGE(PG8_SB(1, 0), b3, voffB); PG8_STAGE(PG8_SB(1, 1), b3 + hsB, voffB); PG8_STAGE(PG8_SA(1, 0), a3, voffA);
            PG8_WAIT_V(8); PG8_WAIT_L(0); PG8_BAR; PG8_MMA(1, 0, At, B0); PG8_MMA(1, 1, At, B1); PG8_BAR; PG8_SCHED;
        }
        if constexpr (ALIGN_EPI) { if (wr == 0) PG8_BAR; }
        if constexpr (!Epi::AFTER_DRAIN) { E(acc, cur, wr, wc, fr, fq); }
        if (!has_next) break;
#pragma unroll
        for (int a = 0; a < 2; ++a)
#pragma unroll
            for (int b = 0; b < 2; ++b)
#pragma unroll
                for (int m = 0; m < 4; ++m)
#pragma unroll
                    for (int n = 0; n < 2; ++n) acc[a][b][m][n] = (f32x4){0.f, 0.f, 0.f, 0.f};
        cur = nxt; cA = nA; cB = nB; ++ui;
        if constexpr (ALIGN_EPI) { if (wr == 1) PG8_BAR; }
    }
    PG8_WAIT_V(0);
    if constexpr (!ALIGN_EPI) { if (wr == 0) PG8_BAR; }
    PG8_BAR;
    if constexpr (Epi::AFTER_DRAIN) { E.fused(acc, cur, wr, wc, fr, fq, lds, wid, lane); }
#undef PG8_SA
#undef PG8_SB
#undef PG8_STAGE
#undef PG8_LDA
#undef PG8_LDB
#undef PG8_MMA
#undef PG8_WAIT_V
#undef PG8_WAIT_L
#undef PG8_BAR
#undef PG8_SCHED
}
}

constexpr int NWAVES = 8;
constexpr int BATCH = 2, SEQ = 8192, D = 1024, M = BATCH * SEQ;
constexpr int INW = 5376, FF = 2816, MEMLEN = 256, MROWS = BATCH * MEMLEN;
constexpr int COL_QA = 0, COL_KA = 512, COL_VA = 640, COL_QB = 768, COL_KB = 2304, COL_VB = 3840;
constexpr float LN_EPS = 1e-5f;
constexpr float ALPHA = 1.189207115002721f;
constexpr float LOG2E = 1.4426950408889634f, LN2 = 0.6931471805599453f;

constexpr size_t MiB = 1u << 20, HMiB = 1u << 19;
constexpr size_t WS_CTL = 0, CTL_ZERO_BYTES = 64 * 1024;
constexpr size_t WS_SLOTS = 1 * MiB;
constexpr size_t WS_WG = 5 * HMiB, WS_WU = 16 * HMiB, WS_WD = 27 * HMiB;
constexpr size_t WS_XA = 19 * MiB;
constexpr size_t WS_WIN = 51 * MiB;
constexpr size_t WS_WOUT = 123 * HMiB;
constexpr size_t WS_WKV = 127 * HMiB;
constexpr size_t WS_GT = 135 * HMiB;
constexpr size_t WS_HT = 143 * HMiB;
constexpr size_t WS_WXQ = 151 * HMiB;
constexpr size_t WS_WXOT = 155 * HMiB;
constexpr size_t WS_KV = 159 * HMiB;
constexpr size_t WS_MEMN = 163 * HMiB;
constexpr size_t WS_LSE = 165 * HMiB;
constexpr size_t WS_ROPE = 84 * MiB;
constexpr size_t WS_Z = 85 * MiB;
constexpr size_t WS_TMP = 85 * MiB;
constexpr size_t WS_XN2 = 149 * MiB;
constexpr size_t WS_P = 181 * MiB;
constexpr size_t WS_GB = 64 * MiB;
constexpr size_t WS_ACT = 152 * MiB;
constexpr size_t WS_TMP2 = 64 * MiB;
constexpr size_t WS_END = 256 * MiB;

constexpr int RING_BYTES = 131072;
constexpr int LDS_BYTES = 147456;

#define GAS __attribute__((address_space(1)))
#define LAS __attribute__((address_space(3)))
typedef unsigned short bf16;
typedef unsigned v4u __attribute__((ext_vector_type(4)));
typedef unsigned v2u __attribute__((ext_vector_type(2)));
typedef float f32x4 __attribute__((ext_vector_type(4)));
#define LDS_WAIT() asm volatile("s_waitcnt lgkmcnt(0)" ::: "memory")

__device__ __forceinline__ unsigned f2bf(float f) { unsigned u = __builtin_bit_cast(unsigned, f); return (u + 0x7fffu + ((u >> 16) & 1u)) >> 16; }
__device__ __forceinline__ unsigned pk2(float lo, float hi) { return f2bf(lo) | (f2bf(hi) << 16); }
__device__ __forceinline__ float bflo(unsigned w) { return __builtin_bit_cast(float, w << 16); }
__device__ __forceinline__ float bfhi(unsigned w) { return __builtin_bit_cast(float, w & 0xffff0000u); }
__device__ __forceinline__ float bf2f(bf16 h) { return __builtin_bit_cast(float, (unsigned)h << 16); }
__device__ __forceinline__ float wave_sum(float v) {
#pragma unroll
    for (int o = 1; o < 64; o <<= 1) v += __shfl_xor(v, o);
    return v;
}
__device__ __forceinline__ float wave_max(float v) {
#pragma unroll
    for (int o = 1; o < 64; o <<= 1) v = fmaxf(v, __shfl_xor(v, o));
    return v;
}

struct Frame {
    LAS unsigned char* lds;
    int tid, lane, wave, G, gw, NGW;
    const float* const* in;
    float* out; unsigned char* ws;
};

__device__ __forceinline__ void p0_transpose_item(const float* W, int K, int N, bf16* WT, int row_off, LAS float* scr, int item, int lane) {
    const int nblk = N / 32, kb = item / nblk, nb = item % nblk, k0 = 64 * kb, n0 = 32 * nb;
#pragma unroll 8
    for (int i = 0; i < 32; ++i) { const int kk = 2 * i + (lane >> 5); scr[kk * 33 + (lane & 31)] = W[(size_t)(k0 + kk) * N + n0 + (lane & 31)]; }
    LDS_WAIT(); asm volatile("" ::: "memory");
    const int c = lane & 7;
#pragma unroll
    for (int j = 0; j < 4; ++j) { const int n = (lane >> 3) + 8 * j; const LAS float* s = scr + (8 * c) * 33 + n;
        v4u o; o.x = pk2(s[0 * 33], s[1 * 33]); o.y = pk2(s[2 * 33], s[3 * 33]); o.z = pk2(s[4 * 33], s[5 * 33]); o.w = pk2(s[6 * 33], s[7 * 33]);
        *(v4u*)(WT + (size_t)(row_off + n0 + n) * K + k0 + 8 * c) = o; }
    LDS_WAIT(); asm volatile("" ::: "memory");
}
__device__ __forceinline__ void ln_row(int lane, const float* xa, float alpha, const float* xb, const float* g, const float* b, float* of, bf16* ob) {
    f32x4 v[4]; float s = 0.f;
#pragma unroll
    for (int j = 0; j < 4; ++j) { v[j] = *((const f32x4*)xa + lane + 64 * j) * alpha; if (xb) v[j] = v[j] + *((const f32x4*)xb + lane + 64 * j); s += (v[j].x + v[j].y) + (v[j].z + v[j].w); }
    const float mean = wave_sum(s) * (1.f / D); float s2 = 0.f;
#pragma unroll
    for (int j = 0; j < 4; ++j) { v[j] = v[j] - mean; s2 += (v[j].x * v[j].x + v[j].y * v[j].y) + (v[j].z * v[j].z + v[j].w * v[j].w); }
    const float rstd = 1.f / sqrtf(wave_sum(s2) * (1.f / D) + LN_EPS);
#pragma unroll
    for (int j = 0; j < 4; ++j) { const f32x4 gg = *((const f32x4*)g + lane + 64 * j), bb = *((const f32x4*)b + lane + 64 * j); const f32x4 y = v[j] * rstd * gg + bb;
        if (of) *((f32x4*)of + lane + 64 * j) = y;
        if (ob) { v2u w; w.x = pk2(y.x, y.y); w.y = pk2(y.z, y.w); *((v2u*)ob + lane + 64 * j) = w; } }
}

__device__ __forceinline__ void p0_prologue(Frame& F) {
    unsigned char* ws = F.ws;
    LAS float* scr = (LAS float*)(F.lds + F.wave * 16384);
    const int gw = F.gw, NGW = F.NGW;
    constexpr int I_DD = (D / 64) * (D / 32);
    constexpr int I_IN = (D / 64) * (INW / 32);
    constexpr int I_FF = (D / 64) * (FF / 32);
    constexpr int I_DN = (FF / 64) * (D / 32);
    constexpr int NITEMS = I_IN + 4 * I_DD + 2 * I_FF + I_DN;
    for (int it = gw; it < NITEMS; it += NGW) {
        int r = it;
        if (r < I_IN) { p0_transpose_item(F.in[5], D, INW, (bf16*)(ws + WS_WIN), 0, scr, r, F.lane); continue; } r -= I_IN;
        if (r < I_DD) { p0_transpose_item(F.in[9], D, D, (bf16*)(ws + WS_WOUT), 0, scr, r, F.lane); continue; } r -= I_DD;
        if (r < I_DD) { p0_transpose_item(F.in[15], D, D, (bf16*)(ws + WS_WKV), 0, scr, r, F.lane); continue; } r -= I_DD;
        if (r < I_DD) { p0_transpose_item(F.in[16], D, D, (bf16*)(ws + WS_WKV), D, scr, r, F.lane); continue; } r -= I_DD;
        if (r < I_DD) { p0_transpose_item(F.in[17], D, D, (bf16*)(ws + WS_WXOT), 0, scr, r, F.lane); continue; } r -= I_DD;
        if (r < I_FF) { p0_transpose_item(F.in[20], D, FF, (bf16*)(ws + WS_WG), 0, scr, r, F.lane); continue; } r -= I_FF;
        if (r < I_FF) { p0_transpose_item(F.in[21], D, FF, (bf16*)(ws + WS_WU), 0, scr, r, F.lane); continue; } r -= I_FF;
        p0_transpose_item(F.in[24], FF, D, (bf16*)(ws + WS_WD), 0, scr, r, F.lane);
    }
    { const float* W = F.in[14]; bf16* O = (bf16*)(ws + WS_WXQ);
      for (int i = gw * 64 + F.lane; i < D * D / 4; i += NGW * 64) { const f32x4 v = *((const f32x4*)W + i); v2u w; w.x = pk2(v.x, v.y); w.y = pk2(v.z, v.w); *((v2u*)O + i) = w; } }
    for (int m = gw; m < M; m += NGW) ln_row(F.lane, F.in[0] + (size_t)m * D, 1.f, nullptr, F.in[3], F.in[4], F.out + (size_t)m * D, (bf16*)(ws + WS_XA) + (size_t)m * D);
    for (int m = gw; m < MROWS; m += NGW) ln_row(F.lane, F.in[1] + (size_t)m * D, 1.f, nullptr, F.in[12], F.in[13], nullptr, (bf16*)(ws + WS_MEMN) + (size_t)m * D);
    { const int* pos = (const int*)F.in[2]; float* ct = (float*)(ws + WS_ROPE); float* st = ct + M * 8;
      for (int i = gw * 64 + F.lane; i < M * 8; i += NGW * 64) { const int m = i >> 3, k = i & 7;
          float invf;
          switch (k) { case 0: invf = 1.0f; break; case 1: invf = 0.19392274474868576f; break; case 2: invf = 0.03760603093086393f; break; case 3: invf = 0.007292664737217109f; break;
                       case 4: invf = 0.001414213562373095f; break; case 5: invf = 0.0002742481756762073f; break; case 6: invf = 5.318295896944988e-05f; break; default: invf = 1.031338537721246e-05f; }
          const float ang = (float)pos[m] * invf;
          const double rev = (double)ang * 0.15915494309189535; const double fr = rev - __builtin_rint(rev);
          const float ff = (float)fr;
          ct[i] = __builtin_amdgcn_cosf(ff); st[i] = __builtin_amdgcn_sinf(ff); } }
}

__device__ __forceinline__ void rope_pass(Frame& F) {
    bf16* Z = (bf16*)(F.ws + WS_Z); const float* ct = (const float*)(F.ws + WS_ROPE); const float* st = ct + M * 8;
    const long total = (long)M * 58 * 8;
    for (long i = (long)F.gw * 64 + F.lane; i < total; i += (long)F.NGW * 64) {
        const int m = (int)(i / 464), rem = (int)(i % 464), hh = rem >> 3, k = rem & 7;
        const int col0 = hh < 10 ? hh * 64 : 768 + (hh - 10) * 64;
        bf16* p = Z + (size_t)m * INW + col0 + k;
        const float t1 = bf2f(p[0]), t2 = bf2f(p[8]), c = ct[m * 8 + k], s = st[m * 8 + k];
        p[0] = (bf16)f2bf(t1 * c - t2 * s); p[8] = (bf16)f2bf(t2 * c + t1 * s);
    }
}

template <int NIT>
__device__ __forceinline__ void attn_naive_item(int lane, bf16* qo, const bf16* Kb, const bf16* Vb, int s, int dil, int nside, float m0, float l0, float* lse_out) {
    float q[64];
    { const v4u* qp = (const v4u*)qo;
#pragma unroll
      for (int j = 0; j < 8; ++j) { const v4u w = qp[j]; q[8 * j + 0] = bflo(w.x); q[8 * j + 1] = bfhi(w.x); q[8 * j + 2] = bflo(w.y); q[8 * j + 3] = bfhi(w.y); q[8 * j + 4] = bflo(w.z); q[8 * j + 5] = bfhi(w.z); q[8 * j + 6] = bflo(w.w); q[8 * j + 7] = bfhi(w.w); } }
    float sc[NIT]; float mx = m0;
#pragma unroll
    for (int it = 0; it < NIT; ++it) {
        const int kidx = it * 64 + lane, t = s + (kidx - nside) * dil; const bool valid = (kidx <= 2 * nside) && t >= 0 && t < SEQ;
        float d = 0.f;
        if (valid) { const v4u* kp = (const v4u*)(Kb + (size_t)t * INW);
#pragma unroll
            for (int j = 0; j < 8; ++j) { const v4u w = kp[j];
                d += q[8 * j + 0] * bflo(w.x) + q[8 * j + 1] * bfhi(w.x) + q[8 * j + 2] * bflo(w.y) + q[8 * j + 3] * bfhi(w.y) + q[8 * j + 4] * bflo(w.z) + q[8 * j + 5] * bfhi(w.z) + q[8 * j + 6] * bflo(w.w) + q[8 * j + 7] * bfhi(w.w); } }
        sc[it] = valid ? d * (0.125f * LOG2E) : -3.0e38f;
        mx = fmaxf(mx, sc[it]);
    }
    mx = wave_max(mx);
    float ls = 0.f;
#pragma unroll
    for (int it = 0; it < NIT; ++it) { sc[it] = (sc[it] > -1.0e38f) ? exp2f(sc[it] - mx) : 0.f; ls += sc[it]; }
    const float l = l0 * exp2f(m0 - mx) + wave_sum(ls);
    float o = 0.f;
#pragma unroll
    for (int it = 0; it < NIT; ++it) {
        for (int j = 0; j < 64; ++j) { const float pj = __shfl(sc[it], j);
            if (pj != 0.f) { const int t = s + (it * 64 + j - nside) * dil; o += pj * bf2f(Vb[(size_t)t * INW + lane]); } }
    }
    qo[lane] = (bf16)f2bf(o / l);
    if (lse_out && lane == 0) *lse_out = (mx + log2f(l)) * LN2;
}
__device__ __forceinline__ void attn_naive_phase(Frame& F) {
    bf16* Z = (bf16*)(F.ws + WS_Z); float* LSE = (float*)(F.ws + WS_LSE); const float* sink = F.in[6];
    const int total = 32 * M;
    for (int i = F.gw; i < total; i += F.NGW) {
        const int Hh = i / M, m = i % M, b = m / SEQ, s = m % SEQ;
        bf16* zb = Z + (size_t)b * SEQ * INW;
        if (Hh < 8) {
            const int kv = Hh >> 2;
            attn_naive_item<5>(F.lane, Z + (size_t)m * INW + COL_QA + Hh * 64, zb + COL_KA + kv * 64, zb + COL_VA + kv * 64, s, 1, 128, sink[Hh] * LOG2E, 1.f, nullptr);
        } else {
            const int hb = Hh - 8, g = hb >> 3, slot = hb & 7; const int dil = g == 0 ? 1 : (g == 1 ? 4 : 16);
            attn_naive_item<3>(F.lane, Z + (size_t)m * INW + COL_QB + hb * 64, zb + COL_KB + hb * 64, zb + COL_VB + hb * 64, s, dil, 64, -1.0e30f, 0.f, LSE + ((size_t)g * M + m) * 8 + slot);
        }
    }
}

__device__ __forceinline__ void combine_phase(Frame& F) {
    const bf16* Z = (const bf16*)(F.ws + WS_Z); const float* LSE = (const float*)(F.ws + WS_LSE); bf16* MX = (bf16*)(F.ws + WS_XA);
    const float* gwin = F.in[7]; const float* gdil = F.in[8];
    const int lane = F.lane;
    for (int m = F.gw; m < M; m += F.NGW) {
        const bf16* zr = Z + (size_t)m * INW;
        float a[8]; { const v4u w = *(const v4u*)(zr + COL_QA + 8 * lane); a[0] = bflo(w.x); a[1] = bfhi(w.x); a[2] = bflo(w.y); a[3] = bfhi(w.y); a[4] = bflo(w.z); a[5] = bfhi(w.z); a[6] = bflo(w.w); a[7] = bfhi(w.w); }
        float ssa = 0.f;
#pragma unroll
        for (int j = 0; j < 8; ++j) ssa += a[j] * a[j];
        ssa = wave_sum(ssa);
        const float ra = 1.f / sqrtf(ssa * (1.f / 512.f) + LN_EPS);
        const int slot = lane >> 3;
        const float l0 = LSE[((size_t)0 * M + m) * 8 + slot], l1 = LSE[((size_t)1 * M + m) * 8 + slot], l2 = LSE[((size_t)2 * M + m) * 8 + slot];
        const float lm = fmaxf(l0, fmaxf(l1, l2)); float w0 = __expf(l0 - lm), w1 = __expf(l1 - lm), w2 = __expf(l2 - lm); const float wi = 1.f / (w0 + w1 + w2); w0 *= wi; w1 *= wi; w2 *= wi;
        float bb[8];
        { const v4u x0 = *(const v4u*)(zr + COL_QB + 0 * 512 + 8 * lane), x1 = *(const v4u*)(zr + COL_QB + 1 * 512 + 8 * lane), x2 = *(const v4u*)(zr + COL_QB + 2 * 512 + 8 * lane);
          bb[0] = w0 * bflo(x0.x) + w1 * bflo(x1.x) + w2 * bflo(x2.x); bb[1] = w0 * bfhi(x0.x) + w1 * bfhi(x1.x) + w2 * bfhi(x2.x);
          bb[2] = w0 * bflo(x0.y) + w1 * bflo(x1.y) + w2 * bflo(x2.y); bb[3] = w0 * bfhi(x0.y) + w1 * bfhi(x1.y) + w2 * bfhi(x2.y);
          bb[4] = w0 * bflo(x0.z) + w1 * bflo(x1.z) + w2 * bflo(x2.z); bb[5] = w0 * bfhi(x0.z) + w1 * bfhi(x1.z) + w2 * bfhi(x2.z);
          bb[6] = w0 * bflo(x0.w) + w1 * bflo(x1.w) + w2 * bflo(x2.w); bb[7] = w0 * bfhi(x0.w) + w1 * bfhi(x1.w) + w2 * bfhi(x2.w); }
        float ssb = 0.f;
#pragma unroll
        for (int j = 0; j < 8; ++j) ssb += bb[j] * bb[j];
        ssb = wave_sum(ssb);
        const float rb = 1.f / sqrtf(ssb * (1.f / 512.f) + LN_EPS);
        const f32x4 ga0 = *(const f32x4*)(gwin + 8 * lane), ga1 = *(const f32x4*)(gwin + 8 * lane + 4), gb0 = *(const f32x4*)(gdil + 8 * lane), gb1 = *(const f32x4*)(gdil + 8 * lane + 4);
        v4u oa, ob;
        oa.x = pk2(a[0] * ra * ga0.x, a[1] * ra * ga0.y); oa.y = pk2(a[2] * ra * ga0.z, a[3] * ra * ga0.w); oa.z = pk2(a[4] * ra * ga1.x, a[5] * ra * ga1.y); oa.w = pk2(a[6] * ra * ga1.z, a[7] * ra * ga1.w);
        ob.x = pk2(bb[0] * rb * gb0.x, bb[1] * rb * gb0.y); ob.y = pk2(bb[2] * rb * gb0.z, bb[3] * rb * gb0.w); ob.z = pk2(bb[4] * rb * gb1.x, bb[5] * rb * gb1.y); ob.w = pk2(bb[6] * rb * gb1.z, bb[7] * rb * gb1.w);
        *(v4u*)(MX + (size_t)m * D + 8 * lane) = oa; *(v4u*)(MX + (size_t)m * D + 512 + 8 * lane) = ob;
    }
}

__device__ __forceinline__ void ln_res_phase(Frame& F, const float* tmp, const float* g, const float* b, bf16* xn) {
    for (int m = F.gw; m < M; m += F.NGW) ln_row(F.lane, F.out + (size_t)m * D, ALPHA, tmp + (size_t)m * D, g, b, F.out + (size_t)m * D, xn ? xn + (size_t)m * D : nullptr);
}
__device__ __forceinline__ void softmax_phase(Frame& F, const float* tmp, bf16* P) {
    const int lane = F.lane;
    for (int m = F.gw; m < M; m += F.NGW) {
#pragma unroll
        for (int h = 0; h < 4; ++h) { const f32x4 v = *((const f32x4*)(tmp + (size_t)m * D + h * 256) + lane);
            const float mx = wave_max(fmaxf(fmaxf(v.x, v.y), fmaxf(v.z, v.w)));
            const float e0 = __expf(v.x - mx), e1 = __expf(v.y - mx), e2 = __expf(v.z - mx), e3 = __expf(v.w - mx);
            const float inv = 1.f / wave_sum((e0 + e1) + (e2 + e3));
            v2u w; w.x = pk2(e0 * inv, e1 * inv); w.y = pk2(e2 * inv, e3 * inv); *((v2u*)(P + (size_t)m * D + h * 256) + lane) = w; }
    }
}
__device__ __forceinline__ float gelu_exact(float x) { return 0.5f * x * (1.f + erff(x * 0.7071067811865476f)); }
__device__ __forceinline__ void convglu_phase(Frame& F, const bf16* Gb, bf16* U) {
    const float* cw = F.in[22]; const float* cb = F.in[23];
    const long total = (long)M * (FF / 8);
    for (long i = (long)F.gw * 64 + F.lane; i < total; i += (long)F.NGW * 64) {
        const int m = (int)(i / (FF / 8)), c8 = (int)(i % (FF / 8)) * 8, s = m % SEQ;
        const v4u zero = {0u, 0u, 0u, 0u};
        const v4u g1 = *(const v4u*)(Gb + (size_t)m * FF + c8);
        const v4u g0 = s > 0 ? *(const v4u*)(Gb + (size_t)(m - 1) * FF + c8) : zero;
        const v4u g2 = s < SEQ - 1 ? *(const v4u*)(Gb + (size_t)(m + 1) * FF + c8) : zero;
        const v4u uu = *(const v4u*)(U + (size_t)m * FF + c8);
        float r[8];
#pragma unroll
        for (int j = 0; j < 8; ++j) { const unsigned a0 = j < 2 ? g0.x : j < 4 ? g0.y : j < 6 ? g0.z : g0.w, a1 = j < 2 ? g1.x : j < 4 ? g1.y : j < 6 ? g1.z : g1.w, a2 = j < 2 ? g2.x : j < 4 ? g2.y : j < 6 ? g2.z : g2.w, au = j < 2 ? uu.x : j < 4 ? uu.y : j < 6 ? uu.z : uu.w;
            const float v0 = (j & 1) ? bfhi(a0) : bflo(a0), v1 = (j & 1) ? bfhi(a1) : bflo(a1), v2 = (j & 1) ? bfhi(a2) : bflo(a2), vu = (j & 1) ? bfhi(au) : bflo(au);
            const int c = c8 + j; const float gc = cw[c] * v0 + cw[FF + c] * v1 + cw[2 * FF + c] * v2 + cb[c];
            r[j] = gelu_exact(gc) * vu; }
        v4u o; o.x = pk2(r[0], r[1]); o.y = pk2(r[2], r[3]); o.z = pk2(r[4], r[5]); o.w = pk2(r[6], r[7]);
        *(v4u*)(U + (size_t)m * FF + c8) = o;
    }
}

struct Args { const float* in[27]; float* out; unsigned char* ws; int ph_lo, ph_hi; };
constexpr int N_PHASES = 16;

__global__ void __launch_bounds__(NWAVES * 64, 2) mega_fwd(Args args) {
    extern __shared__ __attribute__((aligned(16))) unsigned char lds[];
    Frame F;
    F.lds = (LAS unsigned char*)lds;
    F.tid = threadIdx.x; F.lane = F.tid & 63; F.wave = __builtin_amdgcn_readfirstlane(F.tid >> 6);
    F.G = gridDim.x; F.gw = blockIdx.x * NWAVES + F.wave; F.NGW = F.G * NWAVES;
    F.in = args.in;
    F.out = args.out; F.ws = args.ws;
    unsigned char* ws = args.ws;
    const int lo = args.ph_lo, hi = args.ph_hi;
#define IN(k) (lo <= (k) && (k) < hi)
#define SEAM(k) do { if (IN(k) && IN((k) + 1)) { __syncthreads(); cg::this_grid().sync(); } } while (0)
    using namespace pg8;
    const int bx = (int)blockIdx.x;

    if (IN(0)) { p0_prologue(F); } SEAM(0);

    if (IN(1)) {
        { AddrPlain g{(const bf16_t*)(ws + WS_XA), (const bf16_t*)(ws + WS_WIN), D, D}; StaticOrder S; S.init(M, INW, F.G, bx);
          EpiBf16 E{(bf16_t*)(ws + WS_Z), INW, 1.f};
          gemm_phase<EpiBf16, StaticOrder, AddrPlain, true>(F.lds, g, D, S, E); }
        { AddrPlain g{(const bf16_t*)(ws + WS_MEMN), (const bf16_t*)(ws + WS_WKV), D, D}; StaticOrder S; S.init(MROWS, 2 * D, F.G, bx);
          EpiBf16 E{(bf16_t*)(ws + WS_KV), 2 * D, 1.f};
          gemm_phase<EpiBf16, StaticOrder, AddrPlain, true>(F.lds, g, D, S, E); }
    } SEAM(1);

    if (IN(2)) { rope_pass(F); } SEAM(2);

    if (IN(3)) {
        { AddrG g{(const bf16_t*)(ws + WS_KV), (const bf16_t*)(ws + WS_WXQ), 2 * D, D}; StaticOrder S; S.init(2048, D, F.G, bx);
          EpiBf16 E{(bf16_t*)(ws + WS_GT), D, 0.0625f};
          gemm_phase<EpiBf16, StaticOrder, AddrG, true>(F.lds, g, 256, S, E); }
        { AddrH g{(const bf16_t*)(ws + WS_WXOT), (const bf16_t*)(ws + WS_KV), D, 2 * D}; StaticOrder S; S.init(2048, D, F.G, bx);
          EpiBf16 E{(bf16_t*)(ws + WS_HT), D, 1.f};
          gemm_phase<EpiBf16, StaticOrder, AddrH, true>(F.lds, g, 256, S, E); }
        attn_naive_phase(F);
    } SEAM(3);

    if (IN(4)) { combine_phase(F); } SEAM(4);

    if (IN(5)) {
        AddrPlain g{(const bf16_t*)(ws + WS_XA), (const bf16_t*)(ws + WS_WOUT), D, D}; StaticOrder S; S.init(M, D, F.G, bx);
        EpiF32 E{(float*)(ws + WS_TMP), D};
        gemm_phase<EpiF32, StaticOrder, AddrPlain, true>(F.lds, g, D, S, E);
    } SEAM(5);

    if (IN(6)) { ln_res_phase(F, (const float*)(ws + WS_TMP), F.in[10], F.in[11], (bf16*)(ws + WS_XN2)); } SEAM(6);

    if (IN(7)) {
        AddrBatchB g{(const bf16_t*)(ws + WS_XN2), (const bf16_t*)(ws + WS_GT), D, D}; StaticOrder S; S.init(M, D, F.G, bx);
        EpiF32 E{(float*)(ws + WS_TMP), D};
        gemm_phase<EpiF32, StaticOrder, AddrBatchB, true>(F.lds, g, D, S, E);
    } SEAM(7);

    if (IN(8)) { softmax_phase(F, (const float*)(ws + WS_TMP), (bf16*)(ws + WS_P)); } SEAM(8);

    if (IN(9)) {
        AddrBatchB g{(const bf16_t*)(ws + WS_P), (const bf16_t*)(ws + WS_HT), D, D}; StaticOrder S; S.init(M, D, F.G, bx);
        EpiF32 E{(float*)(ws + WS_TMP), D};
        gemm_phase<EpiF32, StaticOrder, AddrBatchB, true>(F.lds, g, D, S, E);
    } SEAM(9);

    if (IN(10)) { ln_res_phase(F, (const float*)(ws + WS_TMP), F.in[18], F.in[19], (bf16*)(ws + WS_XA)); } SEAM(10);

    if (IN(11)) {
        { AddrPlain g{(const bf16_t*)(ws + WS_XA), (const bf16_t*)(ws + WS_WG), D, D}; StaticOrder S; S.init(M, FF, F.G, bx);
          EpiBf16 E{(bf16_t*)(ws + WS_GB), FF, 1.f};
          gemm_phase<EpiBf16, StaticOrder, AddrPlain, true>(F.lds, g, D, S, E); }
        { AddrPlain g{(const bf16_t*)(ws + WS_XA), (const bf16_t*)(ws + WS_WU), D, D}; StaticOrder S; S.init(M, FF, F.G, bx);
          EpiBf16 E{(bf16_t*)(ws + WS_ACT), FF, 1.f};
          gemm_phase<EpiBf16, StaticOrder, AddrPlain, true>(F.lds, g, D, S, E); }
    } SEAM(11);

    if (IN(12)) { convglu_phase(F, (const bf16*)(ws + WS_GB), (bf16*)(ws + WS_ACT)); } SEAM(12);

    if (IN(13)) {
        AddrPlain g{(const bf16_t*)(ws + WS_ACT), (const bf16_t*)(ws + WS_WD), FF, FF}; StaticOrder S; S.init(M, D, F.G, bx);
        EpiF32 E{(float*)(ws + WS_TMP2), D};
        gemm_phase<EpiF32, StaticOrder, AddrPlain, true>(F.lds, g, FF, S, E);
    } SEAM(13);

    if (IN(14)) { ln_res_phase(F, (const float*)(ws + WS_TMP2), F.in[25], F.in[26], nullptr); }
#undef IN
#undef SEAM
}

extern "C" void kernel_launch(void* const* d_in, const int* in_sizes, int n_in, void* d_out, int out_size, void* d_ws, size_t ws_size, hipStream_t stream) {
    static int grid = 0;
    if (grid == 0) {
        if (n_in != 27 || out_size != M * D || ws_size < WS_END) { fprintf(stderr, "kernel_launch: unexpected shapes (n_in %d out %d ws %zu)\n", n_in, out_size, ws_size); grid = -1; return; }
        int dev = 0, cus = 0, per_cu = 0;
        hipGetDevice(&dev); hipDeviceGetAttribute(&cus, hipDeviceAttributeMultiprocessorCount, dev);
        hipFuncSetAttribute((const void*)mega_fwd, hipFuncAttributeMaxDynamicSharedMemorySize, LDS_BYTES);
        hipOccupancyMaxActiveBlocksPerMultiprocessor(&per_cu, (const void*)mega_fwd, NWAVES * 64, LDS_BYTES);
        if (per_cu < 1) { fprintf(stderr, "kernel_launch: occupancy query says %d blocks per CU\n", per_cu); per_cu = 1; }
        (void)hipGetLastError();
        grid = cus;
        fprintf(stderr, "kernel_launch: cus %d per_cu %d grid %d\n", cus, per_cu, grid);
    }
    if (grid < 0) return;
    Args a{};
    for (int i = 0; i < 27; ++i) a.in[i] = (const float*)d_in[i];
    a.out = (float*)d_out; a.ws = (unsigned char*)d_ws;
#if MK_N_LAUNCHES == 1
    a.ph_lo = 0; a.ph_hi = N_PHASES;
    void* kargs[] = {&a};
    hipError_t e = hipLaunchCooperativeKernel((const void*)mega_fwd, dim3(grid), dim3(NWAVES * 64), kargs, LDS_BYTES, stream);
    if (e != hipSuccess) fprintf(stderr, "cooperative launch failed: %s (grid %d)\n", hipGetErrorString(e), grid);
#else
    for (int p = 0; p < 15; ++p) { a.ph_lo = p; a.ph_hi = p + 1; hipLaunchKernelGGL(mega_fwd, dim3(grid), dim3(NWAVES * 64), LDS_BYTES, stream, a); }
#endif
}
```

```cpp
#include <hip/hip_runtime.h>
#include <hip/hip_cooperative_groups.h>
#include <cstdio>
#include <cstdint>
namespace cg = cooperative_groups;

#ifndef MK_N_LAUNCHES
#define MK_N_LAUNCHES 1
#endif

namespace pg8 {
#define PG8_LAS __attribute__((address_space(3)))
typedef unsigned short bf16_t;
typedef short bf16x8 __attribute__((ext_vector_type(8)));
typedef float f32x4 __attribute__((ext_vector_type(4)));
typedef float f32x2 __attribute__((ext_vector_type(2)));
typedef unsigned u32x4 __attribute__((ext_vector_type(4)));
constexpr int BM = 256, BK = 64, HALF = 128, HTB = HALF * BK * 2, STAGE_BYTES = 8 * HTB, NXCD = 8, WGM = 8;

__host__ __device__ __forceinline__ int lds_byte(int r, int c) { const int st = (r >> 4) * 2 + (c >> 5), rr = r & 15, cc = c & 31, ob = rr * 64 + cc * 2; return st * 1024 + (ob ^ (((ob >> 9) & 1) << 5)); }
__host__ __device__ __forceinline__ void stage_rc(int b, int& R, int& C) { const int st = b / 1024, sb = b % 1024, swz = sb ^ (((sb >> 9) & 1) << 5); R = (st >> 1) * 16 + swz / 64; C = (st & 1) * 32 + (swz % 64) / 2; }
__host__ __device__ __forceinline__ int perm32(int rho) { const int n = rho >> 4, i = rho & 15; return 8 * (i >> 2) + 4 * n + (i & 3); }

struct Unit { int pm, pn; };

struct StaticOrder {
    int nM, nN, nwg, G, c;
    __host__ __device__ void init(int M, int N, int G_, int c_) { nM = M / BM; nN = N / BM; nwg = nM * nN; G = G_; c = c_; }
    __host__ __device__ bool next(int i, Unit& u) const {
        const long L = (long)i * G + c; if (L >= nwg) return false;
        int wgid = (int)L; { const int q = nwg / NXCD, r = nwg % NXCD, xcd = wgid % NXCD, off = wgid / NXCD; wgid = (xcd < r ? xcd * (q + 1) : r * (q + 1) + (xcd - r) * q) + off; }
        const int nig = WGM * nN, gid = wgid / nig, fm = gid * WGM, gsz = (nM - fm) < WGM ? (nM - fm) : WGM;
        u.pm = fm + ((wgid % nig) % gsz); u.pn = (wgid % nig) / gsz; return true;
    }
};

struct AddrPlain { const bf16_t* A; const bf16_t* Bt; int lda, ldb;
    __device__ __forceinline__ const char* a(const Unit& u) const { return (const char*)(A + (size_t)u.pm * BM * lda); }
    __device__ __forceinline__ const char* b(const Unit& u) const { return (const char*)(Bt + (size_t)u.pn * BM * ldb); } };
struct AddrBatchB { const bf16_t* A; const bf16_t* Bt; int lda, ldb;
    __device__ __forceinline__ const char* a(const Unit& u) const { return (const char*)(A + (size_t)u.pm * BM * lda); }
    __device__ __forceinline__ const char* b(const Unit& u) const { return (const char*)(Bt + ((size_t)(u.pm >> 5) * 1024 + (size_t)u.pn * BM) * ldb); } };
struct AddrG { const bf16_t* KV; const bf16_t* wq; int lda, ldb;
    __device__ __forceinline__ const char* a(const Unit& u) const { return (const char*)(KV + (size_t)(u.pm >> 2) * 256 * 2048 + (u.pm & 3) * 256); }
    __device__ __forceinline__ const char* b(const Unit& u) const { return (const char*)(wq + (size_t)u.pn * 256 * 1024 + (u.pm & 3) * 256); } };
struct AddrH { const bf16_t* woT; const bf16_t* KV; int lda, ldb;
    __device__ __forceinline__ const char* a(const Unit& u) const { return (const char*)(woT + (size_t)(u.pm & 3) * 256 * 1024 + u.pn * 256); }
    __device__ __forceinline__ const char* b(const Unit& u) const { return (const char*)(KV + (size_t)(u.pm >> 2) * 256 * 2048 + 1024 + u.pn * 256); } };

__device__ __forceinline__ unsigned cvt_pk_bf16(float lo, float hi) { unsigned r; asm volatile("v_cvt_pk_bf16_f32 %0, %1, %2" : "=v"(r) : "v"(lo), "v"(hi)); return r; }

struct EpiBf16 {
    static constexpr bool PERM = true, AFTER_DRAIN = false;
    bf16_t* O; int ldc; float sc;
    __device__ __forceinline__ void operator()(const f32x4 (&acc)[2][2][4][2], const Unit& u, int wr, int wc, int fr, int fq) const {
        const int row0 = u.pm * BM + wr * 64 + fr; const int col0 = u.pn * BM + wc * 32 + 8 * fq;
#pragma unroll
        for (int ai = 0; ai < 2; ++ai)
#pragma unroll
            for (int m = 0; m < 4; ++m) { bf16_t* rowp = O + (size_t)(row0 + ai * HALF + m * 16) * ldc + col0;
#pragma unroll
                for (int bj = 0; bj < 2; ++bj) { f32x4 v0 = acc[ai][bj][m][0] * sc, v1 = acc[ai][bj][m][1] * sc;
                    u32x4 w; w.x = cvt_pk_bf16(v0[0], v0[1]); w.y = cvt_pk_bf16(v0[2], v0[3]); w.z = cvt_pk_bf16(v1[0], v1[1]); w.w = cvt_pk_bf16(v1[2], v1[3]);
                    *(u32x4*)(rowp + bj * HALF) = w; } }
    }
};
struct EpiF32 {
    static constexpr bool PERM = true, AFTER_DRAIN = false;
    float* O; int ldc;
    __device__ __forceinline__ void operator()(const f32x4 (&acc)[2][2][4][2], const Unit& u, int wr, int wc, int fr, int fq) const {
        const int row0 = u.pm * BM + wr * 64 + fr; const int col0 = u.pn * BM + wc * 32 + 8 * fq;
#pragma unroll
        for (int ai = 0; ai < 2; ++ai)
#pragma unroll
            for (int m = 0; m < 4; ++m) { float* rowp = O + (size_t)(row0 + ai * HALF + m * 16) * ldc + col0;
#pragma unroll
                for (int bj = 0; bj < 2; ++bj) { *(f32x4*)(rowp + bj * HALF) = acc[ai][bj][m][0]; *(f32x4*)(rowp + bj * HALF + 4) = acc[ai][bj][m][1]; } }
    }
};

template <class Epi, class Sched, class Addr, bool ALIGN_EPI>
__device__ __forceinline__ void gemm_phase(PG8_LAS unsigned char* lds, const Addr& G, const int K, const Sched& S, const Epi& E) {
    const int tid = threadIdx.x, wid = __builtin_amdgcn_readfirstlane(tid >> 6), lane = tid & 63, wr = wid >> 2, wc = wid & 3, fr = lane & 15, fq = lane >> 4;
    const int nt = K / BK;
    const int lda = G.lda, ldb = G.ldb;
    unsigned voffA[2], voffB[2];
#pragma unroll
    for (int i = 0; i < 2; ++i) { int R, C; stage_rc(tid * 16 + i * 8192, R, C); const int Rb = Epi::PERM ? ((R & ~31) + perm32(R & 31)) : R;
        voffA[i] = (unsigned)(R * lda + C) * 2u; voffB[i] = (unsigned)(Rb * ldb + C) * 2u; }
    const size_t kstep = (size_t)(BK * 2);
    const size_t hsA = (size_t)HALF * lda * 2, hsB = (size_t)HALF * ldb * 2;
    const unsigned ldsw = (unsigned)wid * 1024u;
    const int aoff = lds_byte(wr * 64 + fr, fq * 8), boff = lds_byte(wc * 32 + fr, fq * 8);
#define PG8_SA(b, h) (((b) * 2 + (h)) * HTB)
#define PG8_SB(b, h) ((4 + (b) * 2 + (h)) * HTB)
#define PG8_STAGE(bufoff, gbase, voff) do { _Pragma("unroll") for (int _i = 0; _i < 2; ++_i) \
        __builtin_amdgcn_global_load_lds((const unsigned*)((const char*)(gbase) + (voff)[_i]), (PG8_LAS unsigned*)(lds + (bufoff) + ldsw + _i * 8192), 16, 0, 0); } while (0)
#define PG8_LDA(dst, b, h) do { _Pragma("unroll") for (int m = 0; m < 4; ++m) _Pragma("unroll") for (int k = 0; k < 2; ++k) dst[m][k] = *(const PG8_LAS bf16x8*)(lds + PG8_SA(b, h) + aoff + m * 2048 + k * 1024); } while (0)
#define PG8_LDB(dst, b, h) do { _Pragma("unroll") for (int n = 0; n < 2; ++n) _Pragma("unroll") for (int k = 0; k < 2; ++k) dst[n][k] = *(const PG8_LAS bf16x8*)(lds + PG8_SB(b, h) + boff + n * 2048 + k * 1024); } while (0)
#define PG8_MMA(ai, bj, At, Bt) do { __builtin_amdgcn_s_setprio(1); _Pragma("unroll") for (int m = 0; m < 4; ++m) _Pragma("unroll") for (int n = 0; n < 2; ++n) _Pragma("unroll") for (int k = 0; k < 2; ++k) \
        acc[ai][bj][m][n] = __builtin_amdgcn_mfma_f32_16x16x32_bf16(Bt[n][k], At[m][k], acc[ai][bj][m][n], 0, 0, 0); __builtin_amdgcn_s_setprio(0); } while (0)
#define PG8_WAIT_V(n) asm volatile("s_waitcnt vmcnt(" #n ")" ::: "memory")
#define PG8_WAIT_L(n) asm volatile("s_waitcnt lgkmcnt(" #n ")" ::: "memory")
#define PG8_BAR __builtin_amdgcn_s_barrier()
#define PG8_SCHED __builtin_amdgcn_sched_barrier(0)
    Unit cur, nxt; int ui = 0;
    if (!S.next(0, cur)) return;
    f32x4 acc[2][2][4][2];
#pragma unroll
    for (int a = 0; a < 2; ++a)
#pragma unroll
        for (int b = 0; b < 2; ++b)
#pragma unroll
            for (int m = 0; m < 4; ++m)
#pragma unroll
                for (int n = 0; n < 2; ++n) acc[a][b][m][n] = (f32x4){0.f, 0.f, 0.f, 0.f};
    bf16x8 At[4][2], B0[2][2], B1[2][2];
    const char* cA = G.a(cur); const char* cB = G.b(cur);
    PG8_STAGE(PG8_SB(0, 0), cB, voffB); PG8_STAGE(PG8_SB(0, 1), cB + hsB, voffB); PG8_STAGE(PG8_SA(0, 0), cA, voffA); PG8_STAGE(PG8_SA(0, 1), cA + hsA, voffA);
    if (wr == 1) PG8_BAR;
    PG8_WAIT_V(2); PG8_BAR;
    PG8_STAGE(PG8_SB(1, 0), cB + kstep, voffB); PG8_STAGE(PG8_SA(1, 0), cA + kstep, voffA); PG8_STAGE(PG8_SB(1, 1), cB + hsB + kstep, voffB);
    PG8_WAIT_V(6); PG8_BAR;
    for (;;) {
        const bool has_next = S.next(ui + 1, nxt);
        const char* nA = has_next ? G.a(nxt) : cA; const char* nB = has_next ? G.b(nxt) : cB;
#pragma unroll 1
        for (int t = 0; t < nt; t += 2) {
            const bool last = (t == nt - 2);
            const char* a1 = cA + (size_t)(t + 1) * kstep;
            const char* a2 = last ? nA : cA + (size_t)(t + 2) * kstep; const char* b2 = last ? nB : cB + (size_t)(t + 2) * kstep;
            const char* a3 = a2 + kstep; const char* b3 = b2 + kstep;
            PG8_LDB(B0, 0, 0); PG8_LDB(B1, 0, 1); PG8_SCHED; PG8_LDA(At, 0, 0); PG8_STAGE(PG8_SA(1, 1), a1 + hsA, voffA);
            PG8_WAIT_V(8); PG8_WAIT_L(0); PG8_BAR; PG8_MMA(0, 0, At, B0); PG8_MMA(0, 1, At, B1); PG8_BAR; PG8_SCHED;
            PG8_LDA(At, 0, 1); PG8_STAGE(PG8_SB(0, 0), b2, voffB); PG8_STAGE(PG8_SB(0, 1), b2 + hsB, voffB); PG8_STAGE(PG8_SA(0, 0), a2, voffA);
            PG8_WAIT_V(8); PG8_WAIT_L(0); PG8_BAR; PG8_MMA(1, 0, At, B0); PG8_MMA(1, 1, At, B1); PG8_BAR; PG8_SCHED;
            PG8_LDB(B0, 1, 0); PG8_LDB(B1, 1, 1); PG8_SCHED; PG8_LDA(At, 1, 0); PG8_STAGE(PG8_SA(0, 1), a2 + hsA, voffA);
            PG8_WAIT_V(8); PG8_WAIT_L(0); PG8_BAR; PG8_MMA(0, 0, At, B0); PG8_MMA(0, 1, At, B1); PG8_BAR; PG8_SCHED;
            PG8_LDA(At, 1, 1); PG8_STAGE(PG8_SB(1, 0), b3, voffB); PG8_STAGE(PG8_SB(1, 1), b3 + hsB, voffB); PG8_STAGE(PG8_SA(1, 0), a3, voffA);
            PG8_WAIT_V(8); PG8_WAIT_L(0); PG8_BAR; PG8_MMA(1, 0, At, B0); PG8_MMA(1, 1, At, B1); PG8_BAR; PG8_SCHED;
        }
        if constexpr (ALIGN_EPI) { if (wr == 0) PG8_BAR; }
        if constexpr (!Epi::AFTER_DRAIN) { E(acc, cur, wr, wc, fr, fq); }
        if (!has_next) break;
#pragma unroll
        for (int a = 0; a < 2; ++a)
#pragma unroll
            for (int b = 0; b < 2; ++b)
#pragma unroll
                for (int m = 0; m < 4; ++m)
#pragma unroll
                    for (int n = 0; n < 2; ++n) acc[a][b][m][n] = (f32x4){0.f, 0.f, 0.f, 0.f};
        cur = nxt; cA = nA; cB = nB; ++ui;
        if constexpr (ALIGN_EPI) { if (wr == 1) PG8_BAR; }
    }
    PG8_WAIT_V(0);
    if constexpr (!ALIGN_EPI) { if (wr == 0) PG8_BAR; }
    PG8_BAR;
    if constexpr (Epi::AFTER_DRAIN) { E.fused(acc, cur, wr, wc, fr, fq, lds, wid, lane); }
#undef PG8_SA
#undef PG8_SB
#undef PG8_STAGE
#undef PG8_LDA
#undef PG8_LDB
#undef PG8_MMA
#undef PG8_WAIT_V
#undef PG8_WAIT_L
#undef PG8_BAR
#undef PG8_SCHED
}
}

constexpr int NWAVES = 8;
constexpr int BATCH = 2, SEQ = 8192, D = 1024, M = BATCH * SEQ;
constexpr int INW = 5376, FF = 2816, MEMLEN = 256, MROWS = BATCH * MEMLEN;
constexpr int COL_QA = 0, COL_KA = 512, COL_VA = 640, COL_QB = 768, COL_KB = 2304, COL_VB = 3840;
constexpr float LN_EPS = 1e-5f;
constexpr float ALPHA = 1.189207115002721f;
constexpr float LOG2E = 1.4426950408889634f, LN2 = 0.6931471805599453f;

constexpr size_t MiB = 1u << 20, HMiB = 1u << 19;
constexpr size_t WS_CTL = 0, CTL_ZERO_BYTES = 64 * 1024;
constexpr size_t WS_SLOTS = 1 * MiB;
constexpr size_t WS_WG = 5 * HMiB, WS_WU = 16 * HMiB, WS_WD = 27 * HMiB;
constexpr size_t WS_XA = 19 * MiB;
constexpr size_t WS_WIN = 51 * MiB;
constexpr size_t WS_WOUT = 123 * HMiB;
constexpr size_t WS_WKV = 127 * HMiB;
constexpr size_t WS_GT = 135 * HMiB;
constexpr size_t WS_HT = 143 * HMiB;
constexpr size_t WS_WXQ = 151 * HMiB;
constexpr size_t WS_WXOT = 155 * HMiB;
constexpr size_t WS_KV = 159 * HMiB;
constexpr size_t WS_MEMN = 163 * HMiB;
constexpr size_t WS_LSE = 165 * HMiB;
constexpr size_t WS_ROPE = 84 * MiB;
constexpr size_t WS_Z = 85 * MiB;
constexpr size_t WS_TMP = 85 * MiB;
constexpr size_t WS_XN2 = 149 * MiB;
constexpr size_t WS_P = 181 * MiB;
constexpr size_t WS_GB = 64 * MiB;
constexpr size_t WS_ACT = 152 * MiB;
constexpr size_t WS_TMP2 = 64 * MiB;
constexpr size_t WS_END = 256 * MiB;

constexpr int RING_BYTES = 131072;
constexpr int LDS_BYTES = 147456;

#define GAS __attribute__((address_space(1)))
#define LAS __attribute__((address_space(3)))
typedef unsigned short bf16;
typedef unsigned v4u __attribute__((ext_vector_type(4)));
typedef unsigned v2u __attribute__((ext_vector_type(2)));
typedef float f32x4 __attribute__((ext_vector_type(4)));
#define LDS_WAIT() asm volatile("s_waitcnt lgkmcnt(0)" ::: "memory")

__device__ __forceinline__ unsigned f2bf(float f) { unsigned u = __builtin_bit_cast(unsigned, f); return (u + 0x7fffu + ((u >> 16) & 1u)) >> 16; }
__device__ __forceinline__ unsigned pk2(float lo, float hi) { return f2bf(lo) | (f2bf(hi) << 16); }
__device__ __forceinline__ float bflo(unsigned w) { return __builtin_bit_cast(float, w << 16); }
__device__ __forceinline__ float bfhi(unsigned w) { return __builtin_bit_cast(float, w & 0xffff0000u); }
__device__ __forceinline__ float bf2f(bf16 h) { return __builtin_bit_cast(float, (unsigned)h << 16); }
__device__ __forceinline__ float wave_sum(float v) {
#pragma unroll
    for (int o = 1; o < 64; o <<= 1) v += __shfl_xor(v, o);
    return v;
}
__device__ __forceinline__ float wave_max(float v) {
#pragma unroll
    for (int o = 1; o < 64; o <<= 1) v = fmaxf(v, __shfl_xor(v, o));
    return v;
}

struct Frame {
    LAS unsigned char* lds;
    int tid, lane, wave, G, gw, NGW;
    const float* const* in;
    float* out; unsigned char* ws;
};

__device__ __forceinline__ void p0_transpose_item(const float* W, int K, int N, bf16* WT, int row_off, LAS float* scr, int item, int lane) {
    const int nblk = N / 32, kb = item / nblk, nb = item % nblk, k0 = 64 * kb, n0 = 32 * nb;
#pragma unroll 8
    for (int i = 0; i < 32; ++i) { const int kk = 2 * i + (lane >> 5); scr[kk * 33 + (lane & 31)] = W[(size_t)(k0 + kk) * N + n0 + (lane & 31)]; }
    LDS_WAIT(); asm volatile("" ::: "memory");
    const int c = lane & 7;
#pragma unroll
    for (int j = 0; j < 4; ++j) { const int n = (lane >> 3) + 8 * j; const LAS float* s = scr + (8 * c) * 33 + n;
        v4u o; o.x = pk2(s[0 * 33], s[1 * 33]); o.y = pk2(s[2 * 33], s[3 * 33]); o.z = pk2(s[4 * 33], s[5 * 33]); o.w = pk2(s[6 * 33], s[7 * 33]);
        *(v4u*)(WT + (size_t)(row_off + n0 + n) * K + k0 + 8 * c) = o; }
    LDS_WAIT(); asm volatile("" ::: "memory");
}
__device__ __forceinline__ void ln_row(int lane, const float* xa, float alpha, const float* xb, const float* g, const float* b, float* of, bf16* ob) {
    f32x4 v[4]; float s = 0.f;
#pragma unroll
    for (int j = 0; j < 4; ++j) { v[j] = *((const f32x4*)xa + lane + 64 * j) * alpha; if (xb) v[j] = v[j] + *((const f32x4*)xb + lane + 64 * j); s += (v[j].x + v[j].y) + (v[j].z + v[j].w); }
    const float mean = wave_sum(s) * (1.f / D); float s2 = 0.f;
#pragma unroll
    for (int j = 0; j < 4; ++j) { v[j] = v[j] - mean; s2 += (v[j].x * v[j].x + v[j].y * v[j].y) + (v[j].z * v[j].z + v[j].w * v[j].w); }
    const float rstd = 1.f / sqrtf(wave_sum(s2) * (1.f / D) + LN_EPS);
#pragma unroll
    for (int j = 0; j < 4; ++j) { const f32x4 gg = *((const f32x4*)g + lane + 64 * j), bb = *((const f32x4*)b + lane + 64 * j); const f32x4 y = v[j] * rstd * gg + bb;
        if (of) *((f32x4*)of + lane + 64 * j) = y;
        if (ob) { v2u w; w.x = pk2(y.x, y.y); w.y = pk2(y.z, y.w); *((v2u*)ob + lane + 64 * j) = w; } }
}

__device__ __forceinline__ void p0_prologue(Frame& F) {
    unsigned char* ws = F.ws;
    LAS float* scr = (LAS float*)(F.lds + F.wave * 16384);
    const int gw = F.gw, NGW = F.NGW;
    constexpr int I_DD = (D / 64) * (D / 32);
    constexpr int I_IN = (D / 64) * (INW / 32);
    constexpr int I_FF = (D / 64) * (FF / 32);
    constexpr int I_DN = (FF / 64) * (D / 32);
    constexpr int NITEMS = I_IN + 4 * I_DD + 2 * I_FF + I_DN;
    for (int it = gw; it < NITEMS; it += NGW) {
        int r = it;
        if (r < I_IN) { p0_transpose_item(F.in[5], D, INW, (bf16*)(ws + WS_WIN), 0, scr, r, F.lane); continue; } r -= I_IN;
        if (r < I_DD) { p0_transpose_item(F.in[9], D, D, (bf16*)(ws + WS_WOUT), 0, scr, r, F.lane); continue; } r -= I_DD;
        if (r < I_DD) { p0_transpose_item(F.in[15], D, D, (bf16*)(ws + WS_WKV), 0, scr, r, F.lane); continue; } r -= I_DD;
        if (r < I_DD) { p0_transpose_item(F.in[16], D, D, (bf16*)(ws + WS_WKV), D, scr, r, F.lane); continue; } r -= I_DD;
        if (r < I_DD) { p0_transpose_item(F.in[17], D, D, (bf16*)(ws + WS_WXOT), 0, scr, r, F.lane); continue; } r -= I_DD;
        if (r < I_FF) { p0_transpose_item(F.in[20], D, FF, (bf16*)(ws + WS_WG), 0, scr, r, F.lane); continue; } r -= I_FF;
        if (r < I_FF) { p0_transpose_item(F.in[21], D, FF, (bf16*)(ws + WS_WU), 0, scr, r, F.lane); continue; } r -= I_FF;
        p0_transpose_item(F.in[24], FF, D, (bf16*)(ws + WS_WD), 0, scr, r, F.lane);
    }
    { const float* W = F.in[14]; bf16* O = (bf16*)(ws + WS_WXQ);
      for (int i = gw * 64 + F.lane; i < D * D / 4; i += NGW * 64) { const f32x4 v = *((const f32x4*)W + i); v2u w; w.x = pk2(v.x, v.y); w.y = pk2(v.z, v.w); *((v2u*)O + i) = w; } }
    for (int m = gw; m < M; m += NGW) ln_row(F.lane, F.in[0] + (size_t)m * D, 1.f, nullptr, F.in[3], F.in[4], F.out + (size_t)m * D, (bf16*)(ws + WS_XA) + (size_t)m * D);
    for (int m = gw; m < MROWS; m += NGW) ln_row(F.lane, F.in[1] + (size_t)m * D, 1.f, nullptr, F.in[12], F.in[13], nullptr, (bf16*)(ws + WS_MEMN) + (size_t)m * D);
    { const int* pos = (const int*)F.in[2]; float* ct = (float*)(ws + WS_ROPE); float* st = ct + M * 8;
      for (int i = gw * 64 + F.lane; i < M * 8; i += NGW * 64) { const int m = i >> 3, k = i & 7;
          float invf;
          switch (k) { case 0: invf = 1.0f; break; case 1: invf = 0.19392274474868576f; break; case 2: invf = 0.03760603093086393f; break; case 3: invf = 0.007292664737217109f; break;
                       case 4: invf = 0.001414213562373095f; break; case 5: invf = 0.0002742481756762073f; break; case 6: invf = 5.318295896944988e-05f; break; default: invf = 1.031338537721246e-05f; }
          const float ang = (float)pos[m] * invf;
          const double rev = (double)ang * 0.15915494309189535; const double fr = rev - __builtin_rint(rev);
          const float ff = (float)fr;
          ct[i] = __builtin_amdgcn_cosf(ff); st[i] = __builtin_amdgcn_sinf(ff); } }
}

__device__ __forceinline__ void rope_pass(Frame& F) {
    bf16* Z = (bf16*)(F.ws + WS_Z); const float* ct = (const float*)(F.ws + WS_ROPE); const float* st = ct + M * 8;
    const long total = (long)M * 58 * 8;
    for (long i = (long)F.gw * 64 + F.lane; i < total; i += (long)F.NGW * 64) {
        const int m = (int)(i / 464), rem = (int)(i % 464), hh = rem >> 3, k = rem & 7;
        const int col0 = hh < 10 ? hh * 64 : 768 + (hh - 10) * 64;
        bf16* p = Z + (size_t)m * INW + col0 + k;
        const float t1 = bf2f(p[0]), t2 = bf2f(p[8]), c = ct[m * 8 + k], s = st[m * 8 + k];
        p[0] = (bf16)f2bf(t1 * c - t2 * s); p[8] = (bf16)f2bf(t2 * c + t1 * s);
    }
}

typedef float f32x16 __attribute__((ext_vector_type(16)));
typedef short s16x4 __attribute__((ext_vector_type(4)));
typedef short s16x8 __attribute__((ext_vector_type(8)));
typedef float f32x2_t __attribute__((ext_vector_type(2)));
typedef __bf16 bf16x2_t __attribute__((ext_vector_type(2)));
__device__ __forceinline__ unsigned cvtpk(float lo, float hi) { f32x2_t v = {lo, hi}; bf16x2_t b = __builtin_convertvector(v, bf16x2_t); return __builtin_bit_cast(unsigned, b); }
__device__ __forceinline__ int crow(int i, int h) { return (i & 3) + 8 * (i >> 2) + 4 * h; }
__device__ __forceinline__ s16x4 vtr(const LAS unsigned char* p) { return __builtin_bit_cast(s16x4, __builtin_amdgcn_ds_read_tr16_b64_v4i16((LAS s16x4*)p)); }

__device__ __forceinline__ void attn_mfma_item(int lane, LAS unsigned char* vl, bf16* Zb, int qcol, int kcol, int vcol, int c, int j0, int dil, int nside, float m0, float l0, float* lse_out) {
    const int r = lane & 31, h = lane >> 5;
    const int L = SEQ / dil, NT = 2 * nside / 32 + 1;
    const int qtok = c + dil * (j0 + r);
    bf16* qp = Zb + (size_t)qtok * INW + qcol;
    s16x8 qf[4];
#pragma unroll
    for (int ks = 0; ks < 4; ++ks) qf[ks] = *(const s16x8*)(qp + 16 * ks + 8 * h);
    float mrow = m0, lrow = (h == 0) ? l0 : 0.f;
    f32x16 o0, o1;
#pragma unroll
    for (int i = 0; i < 16; ++i) { o0[i] = 0.f; o1[i] = 0.f; }
    int t_lo = (nside - j0) / 32; if (t_lo < 0) t_lo = 0;
    int t_hi = (L - 32 - j0 + nside) / 32; if (t_hi > NT - 1) t_hi = NT - 1;
    const int vkey = lane >> 3, c8 = lane & 7;
    const int vlw = (c8 >> 2) * 2048 + vkey * 64 + (c8 & 3) * 16;
    const int i16 = lane & 15, vlr = (4 * h + (i16 >> 2)) * 64 + ((lane >> 4) & 1) * 32 + (i16 & 3) * 8;
    const float SC = 0.125f * LOG2E;
    for (int t = t_lo; t <= t_hi; ++t) {
        const int jk0 = j0 - nside + 32 * t;
        const bf16* kp = Zb + (size_t)(c + dil * (jk0 + r)) * INW + kcol + 8 * h;
        s16x8 kf[4];
#pragma unroll
        for (int ks = 0; ks < 4; ++ks) kf[ks] = *(const s16x8*)(kp + 16 * ks);
        v4u vr[4];
#pragma unroll
        for (int i = 0; i < 4; ++i) vr[i] = *(const v4u*)(Zb + (size_t)(c + dil * (jk0 + i * 8 + vkey)) * INW + vcol + c8 * 8);
        f32x16 p;
#pragma unroll
        for (int i = 0; i < 16; ++i) p[i] = 0.f;
#pragma unroll
        for (int ks = 0; ks < 4; ++ks) p = __builtin_amdgcn_mfma_f32_32x32x16_bf16(kf[ks], qf[ks], p, 0, 0, 0);
#pragma unroll
        for (int i = 0; i < 4; ++i) *(LAS v4u*)(vl + vlw + i * 512) = vr[i];
        const bool first = (t == 0), lastt = (t == NT - 1);
        float mx = -3.0e38f;
#pragma unroll
        for (int i = 0; i < 16; ++i) { float sv = p[i] * SC; const int cr = crow(i, h); if ((first && cr < r) || (lastt && cr > r)) sv = -3.0e38f; p[i] = sv; mx = fmaxf(mx, sv); }
        mx = fmaxf(mx, __shfl_xor(mx, 32));
        const float mnew = fmaxf(mrow, mx), alpha = __builtin_amdgcn_exp2f(mrow - mnew); mrow = mnew;
        float ls = 0.f;
#pragma unroll
        for (int i = 0; i < 16; ++i) { p[i] = __builtin_amdgcn_exp2f(p[i] - mnew); ls += p[i]; }
        lrow = lrow * alpha + ls;
#pragma unroll
        for (int i = 0; i < 16; ++i) { o0[i] *= alpha; o1[i] *= alpha; }
        s16x8 pa[2];
#pragma unroll
        for (int s = 0; s < 2; ++s) { v4u w; w.x = cvtpk(p[8 * s + 0], p[8 * s + 1]); w.y = cvtpk(p[8 * s + 2], p[8 * s + 3]); w.z = cvtpk(p[8 * s + 4], p[8 * s + 5]); w.w = cvtpk(p[8 * s + 6], p[8 * s + 7]); pa[s] = __builtin_bit_cast(s16x8, w); }
#pragma unroll
        for (int s = 0; s < 2; ++s) {
            const s16x4 lo0 = vtr(vl + vlr + s * 1024), hi0 = vtr(vl + vlr + s * 1024 + 512), lo1 = vtr(vl + 2048 + vlr + s * 1024), hi1 = vtr(vl + 2048 + vlr + s * 1024 + 512);
            const s16x8 v0 = __builtin_shufflevector(lo0, hi0, 0, 1, 2, 3, 4, 5, 6, 7), v1 = __builtin_shufflevector(lo1, hi1, 0, 1, 2, 3, 4, 5, 6, 7);
            o0 = __builtin_amdgcn_mfma_f32_32x32x16_bf16(v0, pa[s], o0, 0, 0, 0);
            o1 = __builtin_amdgcn_mfma_f32_32x32x16_bf16(v1, pa[s], o1, 0, 0, 0);
        }
    }
    lrow += __shfl_xor(lrow, 32);
    const float inv = 1.f / lrow;
#pragma unroll
    for (int g4 = 0; g4 < 4; ++g4) {
        v2u w0, w1;
        w0.x = cvtpk(o0[4 * g4 + 0] * inv, o0[4 * g4 + 1] * inv); w0.y = cvtpk(o0[4 * g4 + 2] * inv, o0[4 * g4 + 3] * inv);
        w1.x = cvtpk(o1[4 * g4 + 0] * inv, o1[4 * g4 + 1] * inv); w1.y = cvtpk(o1[4 * g4 + 2] * inv, o1[4 * g4 + 3] * inv);
        *(v2u*)(qp + 8 * g4 + 4 * h) = w0; *(v2u*)(qp + 32 + 8 * g4 + 4 * h) = w1;
    }
    if (lse_out && h == 0) lse_out[(size_t)qtok * 8] = (mrow + __builtin_amdgcn_logf(lrow)) * LN2;
}
__device__ __forceinline__ void attn_mfma_phase(Frame& F) {
    bf16* Z = (bf16*)(F.ws + WS_Z); float* LSE = (float*)(F.ws + WS_LSE); const float* sink = F.in[6];
    LAS unsigned char* vl = F.lds + F.wave * 4096;
    for (int k = 0; k < 8; ++k) {
        const int idx = (k < 2 ? k : k - 2) * F.NGW + F.gw;
        if (k < 2) {
            if (idx >= 4096) continue;
            const int b = idx >> 11, rem = idx & 2047, Hh = rem >> 8, it = rem & 255, kv = Hh >> 2;
            attn_mfma_item(F.lane, vl, Z + (size_t)b * SEQ * INW, COL_QA + Hh * 64, COL_KA + kv * 64, COL_VA + kv * 64, 0, it * 32, 1, 128, sink[Hh] * LOG2E, 1.f, nullptr);
        } else {
            if (idx >= 12288) continue;
            const int b = idx / 6144, rem = idx % 6144, hb = rem >> 8, it = rem & 255, g = hb >> 3, slot = hb & 7;
            const int dil = g == 0 ? 1 : (g == 1 ? 4 : 16), npr = 256 / dil;
            attn_mfma_item(F.lane, vl, Z + (size_t)b * SEQ * INW, COL_QB + hb * 64, COL_KB + hb * 64, COL_VB + hb * 64, it / npr, (it % npr) * 32, dil, 64, -1.0e30f, 0.f,
                           LSE + ((size_t)g * M + (size_t)b * SEQ) * 8 + slot);
        }
    }
}

__device__ __forceinline__ void combine_phase(Frame& F) {
    const bf16* Z = (const bf16*)(F.ws + WS_Z); const float* LSE = (const float*)(F.ws + WS_LSE); bf16* MX = (bf16*)(F.ws + WS_XA);
    const float* gwin = F.in[7]; const float* gdil = F.in[8];
    const int lane = F.lane;
    for (int m = F.gw; m < M; m += F.NGW) {
        const bf16* zr = Z + (size_t)m * INW;
        float a[8]; { const v4u w = *(const v4u*)(zr + COL_QA + 8 * lane); a[0] = bflo(w.x); a[1] = bfhi(w.x); a[2] = bflo(w.y); a[3] = bfhi(w.y); a[4] = bflo(w.z); a[5] = bfhi(w.z); a[6] = bflo(w.w); a[7] = bfhi(w.w); }
        float ssa = 0.f;
#pragma unroll
        for (int j = 0; j < 8; ++j) ssa += a[j] * a[j];
        ssa = wave_sum(ssa);
        const float ra = 1.f / sqrtf(ssa * (1.f / 512.f) + LN_EPS);
        const int slot = lane >> 3;
        const float l0 = LSE[((size_t)0 * M + m) * 8 + slot], l1 = LSE[((size_t)1 * M + m) * 8 + slot], l2 = LSE[((size_t)2 * M + m) * 8 + slot];
        const float lm = fmaxf(l0, fmaxf(l1, l2)); float w0 = __expf(l0 - lm), w1 = __expf(l1 - lm), w2 = __expf(l2 - lm); const float wi = 1.f / (w0 + w1 + w2); w0 *= wi; w1 *= wi; w2 *= wi;
        float bb[8];
        { const v4u x0 = *(const v4u*)(zr + COL_QB + 0 * 512 + 8 * lane), x1 = *(const v4u*)(zr + COL_QB + 1 * 512 + 8 * lane), x2 = *(const v4u*)(zr + COL_QB + 2 * 512 + 8 * lane);
          bb[0] = w0 * bflo(x0.x) + w1 * bflo(x1.x) + w2 * bflo(x2.x); bb[1] = w0 * bfhi(x0.x) + w1 * bfhi(x1.x) + w2 * bfhi(x2.x);
          bb[2] = w0 * bflo(x0.y) + w1 * bflo(x1.y) + w2 * bflo(x2.y); bb[3] = w0 * bfhi(x0.y) + w1 * bfhi(x1.y) + w2 * bfhi(x2.y);
          bb[4] = w0 * bflo(x0.z) + w1 * bflo(x1.z) + w2 * bflo(x2.z); bb[5] = w0 * bfhi(x0.z) + w1 * bfhi(x1.z) + w2 * bfhi(x2.z);
          bb[6] = w0 * bflo(x0.w) + w1 * bflo(x1.w) + w2 * bflo(x2.w); bb[7] = w0 * bfhi(x0.w) + w1 * bfhi(x1.w) + w2 * bfhi(x2.w); }
        float ssb = 0.f;
#pragma unroll
        for (int j = 0; j < 8; ++j) ssb += bb[j] * bb[j];
        ssb = wave_sum(ssb);
        const float rb = 1.f / sqrtf(ssb * (1.f / 512.f) + LN_EPS);
        const f32x4 ga0 = *(const f32x4*)(gwin + 8 * lane), ga1 = *(const f32x4*)(gwin + 8 * lane + 4), gb0 = *(const f32x4*)(gdil + 8 * lane), gb1 = *(const f32x4*)(gdil + 8 * lane + 4);
        v4u oa, ob;
        oa.x = pk2(a[0] * ra * ga0.x, a[1] * ra * ga0.y); oa.y = pk2(a[2] * ra * ga0.z, a[3] * ra * ga0.w); oa.z = pk2(a[4] * ra * ga1.x, a[5] * ra * ga1.y); oa.w = pk2(a[6] * ra * ga1.z, a[7] * ra * ga1.w);
        ob.x = pk2(bb[0] * rb * gb0.x, bb[1] * rb * gb0.y); ob.y = pk2(bb[2] * rb * gb0.z, bb[3] * rb * gb0.w); ob.z = pk2(bb[4] * rb * gb1.x, bb[5] * rb * gb1.y); ob.w = pk2(bb[6] * rb * gb1.z, bb[7] * rb * gb1.w);
        *(v4u*)(MX + (size_t)m * D + 8 * lane) = oa; *(v4u*)(MX + (size_t)m * D + 512 + 8 * lane) = ob;
    }
}

__device__ __forceinline__ void ln_res_phase(Frame& F, const float* tmp, const float* g, const float* b, bf16* xn) {
    for (int m = F.gw; m < M; m += F.NGW) ln_row(F.lane, F.out + (size_t)m * D, ALPHA, tmp + (size_t)m * D, g, b, F.out + (size_t)m * D, xn ? xn + (size_t)m * D : nullptr);
}
__device__ __forceinline__ void softmax_phase(Frame& F, const float* tmp, bf16* P) {
    const int lane = F.lane;
    for (int m = F.gw; m < M; m += F.NGW) {
#pragma unroll
        for (int h = 0; h < 4; ++h) { const f32x4 v = *((const f32x4*)(tmp + (size_t)m * D + h * 256) + lane);
            const float mx = wave_max(fmaxf(fmaxf(v.x, v.y), fmaxf(v.z, v.w)));
            const float e0 = __expf(v.x - mx), e1 = __expf(v.y - mx), e2 = __expf(v.z - mx), e3 = __expf(v.w - mx);
            const float inv = 1.f / wave_sum((e0 + e1) + (e2 + e3));
            v2u w; w.x = pk2(e0 * inv, e1 * inv); w.y = pk2(e2 * inv, e3 * inv); *((v2u*)(P + (size_t)m * D + h * 256) + lane) = w; }
    }
}
__device__ __forceinline__ float gelu_exact(float x) { return 0.5f * x * (1.f + erff(x * 0.7071067811865476f)); }
__device__ __forceinline__ void convglu_phase(Frame& F, const bf16* Gb, bf16* U) {
    const float* cw = F.in[22]; const float* cb = F.in[23];
    const long total = (long)M * (FF / 8);
    for (long i = (long)F.gw * 64 + F.lane; i < total; i += (long)F.NGW * 64) {
        const int m = (int)(i / (FF / 8)), c8 = (int)(i % (FF / 8)) * 8, s = m % SEQ;
        const v4u zero = {0u, 0u, 0u, 0u};
        const v4u g1 = *(const v4u*)(Gb + (size_t)m * FF + c8);
        const v4u g0 = s > 0 ? *(const v4u*)(Gb + (size_t)(m - 1) * FF + c8) : zero;
        const v4u g2 = s < SEQ - 1 ? *(const v4u*)(Gb + (size_t)(m + 1) * FF + c8) : zero;
        const v4u uu = *(const v4u*)(U + (size_t)m * FF + c8);
        float r[8];
#pragma unroll
        for (int j = 0; j < 8; ++j) { const unsigned a0 = j < 2 ? g0.x : j < 4 ? g0.y : j < 6 ? g0.z : g0.w, a1 = j < 2 ? g1.x : j < 4 ? g1.y : j < 6 ? g1.z : g1.w, a2 = j < 2 ? g2.x : j < 4 ? g2.y : j < 6 ? g2.z : g2.w, au = j < 2 ? uu.x : j < 4 ? uu.y : j < 6 ? uu.z : uu.w;
            const float v0 = (j & 1) ? bfhi(a0) : bflo(a0), v1 = (j & 1) ? bfhi(a1) : bflo(a1), v2 = (j & 1) ? bfhi(a2) : bflo(a2), vu = (j & 1) ? bfhi(au) : bflo(au);
            const int c = c8 + j; const float gc = cw[c] * v0 + cw[FF + c] * v1 + cw[2 * FF + c] * v2 + cb[c];
            r[j] = gelu_exact(gc) * vu; }
        v4u o; o.x = pk2(r[0], r[1]); o.y = pk2(r[2], r[3]); o.z = pk2(r[4], r[5]); o.w = pk2(r[6], r[7]);
        *(v4u*)(U + (size_t)m * FF + c8) = o;
    }
}

struct Args { const float* in[27]; float* out; unsigned char* ws; int ph_lo, ph_hi; };
constexpr int N_PHASES = 16;

__global__ void __launch_bounds__(NWAVES * 64, 2) mega_fwd(Args args) {
    extern __shared__ __attribute__((aligned(16))) unsigned char lds[];
    Frame F;
    F.lds = (LAS unsigned char*)lds;
    F.tid = threadIdx.x; F.lane = F.tid & 63; F.wave = __builtin_amdgcn_readfirstlane(F.tid >> 6);
    F.G = gridDim.x; F.gw = blockIdx.x * NWAVES + F.wave; F.NGW = F.G * NWAVES;
    F.in = args.in;
    F.out = args.out; F.ws = args.ws;
    unsigned char* ws = args.ws;
    const int lo = args.ph_lo, hi = args.ph_hi;
#define IN(k) (lo <= (k) && (k) < hi)
#define SEAM(k) do { if (IN(k) && IN((k) + 1)) { __syncthreads(); cg::this_grid().sync(); } } while (0)
    using namespace pg8;
    const int bx = (int)blockIdx.x;

    if (IN(0)) { p0_prologue(F); } SEAM(0);

    if (IN(1)) {
        { AddrPlain g{(const bf16_t*)(ws + WS_XA), (const bf16_t*)(ws + WS_WIN), D, D}; StaticOrder S; S.init(M, INW, F.G, bx);
          EpiBf16 E{(bf16_t*)(ws + WS_Z), INW, 1.f};
          gemm_phase<EpiBf16, StaticOrder, AddrPlain, true>(F.lds, g, D, S, E); }
        { AddrPlain g{(const bf16_t*)(ws + WS_MEMN), (const bf16_t*)(ws + WS_WKV), D, D}; StaticOrder S; S.init(MROWS, 2 * D, F.G, bx);
          EpiBf16 E{(bf16_t*)(ws + WS_KV), 2 * D, 1.f};
          gemm_phase<EpiBf16, StaticOrder, AddrPlain, true>(F.lds, g, D, S, E); }
    } SEAM(1);

    if (IN(2)) { rope_pass(F); } SEAM(2);

    if (IN(3)) {
        { AddrG g{(const bf16_t*)(ws + WS_KV), (const bf16_t*)(ws + WS_WXQ), 2 * D, D}; StaticOrder S; S.init(2048, D, F.G, bx);
          EpiBf16 E{(bf16_t*)(ws + WS_GT), D, 0.0625f};
          gemm_phase<EpiBf16, StaticOrder, AddrG, true>(F.lds, g, 256, S, E); }
        { AddrH g{(const bf16_t*)(ws + WS_WXOT), (const bf16_t*)(ws + WS_KV), D, 2 * D}; StaticOrder S; S.init(2048, D, F.G, bx);
          EpiBf16 E{(bf16_t*)(ws + WS_HT), D, 1.f};
          gemm_phase<EpiBf16, StaticOrder, AddrH, true>(F.lds, g, 256, S, E); }
        attn_mfma_phase(F);
    } SEAM(3);

    if (IN(4)) { combine_phase(F); } SEAM(4);

    if (IN(5)) {
        AddrPlain g{(const bf16_t*)(ws + WS_XA), (const bf16_t*)(ws + WS_WOUT), D, D}; StaticOrder S; S.init(M, D, F.G, bx);
        EpiF32 E{(float*)(ws + WS_TMP), D};
        gemm_phase<EpiF32, StaticOrder, AddrPlain, true>(F.lds, g, D, S, E);
    } SEAM(5);

    if (IN(6)) { ln_res_phase(F, (const float*)(ws + WS_TMP), F.in[10], F.in[11], (bf16*)(ws + WS_XN2)); } SEAM(6);

    if (IN(7)) {
        AddrBatchB g{(const bf16_t*)(ws + WS_XN2), (const bf16_t*)(ws + WS_GT), D, D}; StaticOrder S; S.init(M, D, F.G, bx);
        EpiF32 E{(float*)(ws + WS_TMP), D};
        gemm_phase<EpiF32, StaticOrder, AddrBatchB, true>(F.lds, g, D, S, E);
    } SEAM(7);

    if (IN(8)) { softmax_phase(F, (const float*)(ws + WS_TMP), (bf16*)(ws + WS_P)); } SEAM(8);

    if (IN(9)) {
        AddrBatchB g{(const bf16_t*)(ws + WS_P), (const bf16_t*)(ws + WS_HT), D, D}; StaticOrder S; S.init(M, D, F.G, bx);
        EpiF32 E{(float*)(ws + WS_TMP), D};
        gemm_phase<EpiF32, StaticOrder, AddrBatchB, true>(F.lds, g, D, S, E);
    } SEAM(9);

    if (IN(10)) { ln_res_phase(F, (const float*)(ws + WS_TMP), F.in[18], F.in[19], (bf16*)(ws + WS_XA)); } SEAM(10);

    if (IN(11)) {
        { AddrPlain g{(const bf16_t*)(ws + WS_XA), (const bf16_t*)(ws + WS_WG), D, D}; StaticOrder S; S.init(M, FF, F.G, bx);
          EpiBf16 E{(bf16_t*)(ws + WS_GB), FF, 1.f};
          gemm_phase<EpiBf16, StaticOrder, AddrPlain, true>(F.lds, g, D, S, E); }
        { AddrPlain g{(const bf16_t*)(ws + WS_XA), (const bf16_t*)(ws + WS_WU), D, D}; StaticOrder S; S.init(M, FF, F.G, bx);
          EpiBf16 E{(bf16_t*)(ws + WS_ACT), FF, 1.f};
          gemm_phase<EpiBf16, StaticOrder, AddrPlain, true>(F.lds, g, D, S, E); }
    } SEAM(11);

    if (IN(12)) { convglu_phase(F, (const bf16*)(ws + WS_GB), (bf16*)(ws + WS_ACT)); } SEAM(12);

    if (IN(13)) {
        AddrPlain g{(const bf16_t*)(ws + WS_ACT), (const bf16_t*)(ws + WS_WD), FF, FF}; StaticOrder S; S.init(M, D, F.G, bx);
        EpiF32 E{(float*)(ws + WS_TMP2), D};
        gemm_phase<EpiF32, StaticOrder, AddrPlain, true>(F.lds, g, FF, S, E);
    } SEAM(13);

    if (IN(14)) { ln_res_phase(F, (const float*)(ws + WS_TMP2), F.in[25], F.in[26], nullptr); }
#undef IN
#undef SEAM
}

extern "C" void kernel_launch(void* const* d_in, const int* in_sizes, int n_in, void* d_out, int out_size, void* d_ws, size_t ws_size, hipStream_t stream) {
    static int grid = 0;
    if (grid == 0) {
        if (n_in != 27 || out_size != M * D || ws_size < WS_END) { fprintf(stderr, "kernel_launch: unexpected shapes (n_in %d out %d ws %zu)\n", n_in, out_size, ws_size); grid = -1; return; }
        int dev = 0, cus = 0, per_cu = 0;
        hipGetDevice(&dev); hipDeviceGetAttribute(&cus, hipDeviceAttributeMultiprocessorCount, dev);
        hipFuncSetAttribute((const void*)mega_fwd, hipFuncAttributeMaxDynamicSharedMemorySize, LDS_BYTES);
        hipOccupancyMaxActiveBlocksPerMultiprocessor(&per_cu, (const void*)mega_fwd, NWAVES * 64, LDS_BYTES);
        if (per_cu < 1) { fprintf(stderr, "kernel_launch: occupancy query says %d blocks per CU\n", per_cu); per_cu = 1; }
        (void)hipGetLastError();
        grid = cus;
        fprintf(stderr, "kernel_launch: cus %d per_cu %d grid %d\n", cus, per_cu, grid);
    }
    if (grid < 0) return;
    Args a{};
    for (int i = 0; i < 27; ++i) a.in[i] = (const float*)d_in[i];
    a.out = (float*)d_out; a.ws = (unsigned char*)d_ws;
#if MK_N_LAUNCHES == 1
    a.ph_lo = 0; a.ph_hi = N_PHASES;
    void* kargs[] = {&a};
    hipError_t e = hipLaunchCooperativeKernel((const void*)mega_fwd, dim3(grid), dim3(NWAVES * 64), kargs, LDS_BYTES, stream);
    if (e != hipSuccess) fprintf(stderr, "cooperative launch failed: %s (grid %d)\n", hipGetErrorString(e), grid);
#else
    for (int p = 0; p < 15; ++p) { a.ph_lo = p; a.ph_hi = p + 1; hipLaunchKernelGGL(mega_fwd, dim3(grid), dim3(NWAVES * 64), LDS_BYTES, stream, a); }
#endif
}
```
